# Optimizing an MI355X kernel written in HIP

```python
import math
import jax, jax.numpy as jnp
from jax import lax
import numpy as np

D_MODEL = 1024
BATCH = 8
SEQ = 4096
DEPTH = 2

D_MIX = D_MODEL
SSD_HEADS = 8
SSD_HEAD_DIM = 64
SSD_INNER = SSD_HEADS * SSD_HEAD_DIM
SSD_GROUPS = 2
SSD_STATE = 128
SSD_CONV = 4
SSD_CHUNK = 128
SSD_XBC = SSD_INNER + 2 * SSD_GROUPS * SSD_STATE
ATT_Q_HEADS = 4
ATT_KV_HEADS = 2
ATT_HEAD_DIM = 64
ATT_WIDTH = ATT_Q_HEADS * ATT_HEAD_DIM
ATT_KV_WIDTH = ATT_KV_HEADS * ATT_HEAD_DIM
WINDOW = 128
REL_BUCKETS = 32
REL_MAX_DIST = 128
GM_GROUPS = 4
GM_GROUP_DIM = 64
GM_WIDTH = GM_GROUPS * GM_GROUP_DIM
GM_CHUNK = 128
D_FF = 2816
EPS = 1e-6

OFF_Z = 0
OFF_XBC = OFF_Z + SSD_INNER
OFF_DT = OFF_XBC + SSD_XBC
OFF_Q = OFF_DT + SSD_HEADS
OFF_K = OFF_Q + ATT_WIDTH
OFF_V = OFF_K + ATT_KV_WIDTH
OFF_U = OFF_V + ATT_KV_WIDTH
OFF_GV = OFF_U + GM_WIDTH
D_IN_PROJ = OFF_GV + GM_WIDTH

kernel_name = "hybrid_ssd_swa_sgu_macaron"


def rmsnorm(x, w):
    xf = x.astype(jnp.float32)
    y = xf * lax.rsqrt(jnp.mean(xf * xf, axis=-1, keepdims=True) + EPS)
    return (y * w.astype(jnp.float32)).astype(x.dtype)


def layernorm(x, w, b):
    xf = x.astype(jnp.float32)
    mu = jnp.mean(xf, axis=-1, keepdims=True)
    xc = xf - mu
    y = xc * lax.rsqrt(jnp.mean(xc * xc, axis=-1, keepdims=True) + EPS)
    return (y * w.astype(jnp.float32) + b.astype(jnp.float32)).astype(x.dtype)


def swiglu(x, w_gate, w_up, w_down):
    return (jax.nn.silu(x @ w_gate) * (x @ w_up)) @ w_down


def causal_depthwise_conv(x, w, b):
    c = x.shape[-1]
    y = lax.conv_general_dilated(
        x, w.astype(x.dtype)[:, None, :], window_strides=(1,),
        padding=[(SSD_CONV - 1, 0)], dimension_numbers=("NWC", "WIO", "NWC"),
        feature_group_count=c)
    return y + b.astype(x.dtype)


def ssd_mixer(z, xbc_raw, dt_raw, conv_w, conv_b, dt_bias, a_log, d_skip, norm_w):
    bsz, s, _ = z.shape
    L, G, N, P = SSD_CHUNK, SSD_GROUPS, SSD_STATE, SSD_HEAD_DIM
    hpg = SSD_HEADS // G
    nc = s // L
    xbc = jax.nn.silu(causal_depthwise_conv(xbc_raw, conv_w, conv_b))
    x = xbc[..., :SSD_INNER].reshape(bsz, nc, L, G, hpg, P)
    bm = xbc[..., SSD_INNER:SSD_INNER + G * N].reshape(bsz, nc, L, G, N)
    cm = xbc[..., SSD_INNER + G * N:].reshape(bsz, nc, L, G, N)
    dt = jax.nn.softplus(dt_raw.astype(jnp.float32) + dt_bias.astype(jnp.float32))
    dt = dt.reshape(bsz, nc, L, G, hpg)
    a = dt * (-jnp.exp(a_log.astype(jnp.float32))).reshape(G, hpg)
    a_cs = jnp.cumsum(a, axis=2)
    xdt = x * dt[..., None].astype(x.dtype)
    causal = jnp.tril(jnp.ones((L, L), dtype=bool))[None, None, :, :, None, None]
    seg = a_cs[:, :, :, None] - a_cs[:, :, None]
    decay = jnp.exp(jnp.where(causal, seg, -jnp.inf)).astype(x.dtype)
    cb = jnp.einsum('bclgn,bcsgn->bclsg', cm, bm)
    y_diag = jnp.einsum('bclsgh,bcsghp->bclghp', cb[..., None] * decay, xdt)
    decay_end = jnp.exp(a_cs[:, :, -1:] - a_cs).astype(x.dtype)
    states = jnp.einsum('bclgn,bclghp->bcghpn', bm, xdt * decay_end[..., None])
    chunk_decay = jnp.exp(a_cs[:, :, -1])

    def step(carry, inp):
        st, dec = inp
        return carry * dec[..., None, None] + st, carry

    init = jnp.zeros((bsz, G, hpg, P, N), jnp.float32)
    _, prev = lax.scan(step, init, (jnp.swapaxes(states.astype(jnp.float32), 0, 1),
                                    jnp.swapaxes(chunk_decay, 0, 1)))
    prev = jnp.swapaxes(prev, 0, 1).astype(x.dtype)
    y_off = jnp.einsum('bclgn,bcghpn->bclghp', cm, prev) * jnp.exp(a_cs)[..., None].astype(x.dtype)
    y = y_diag + y_off + x * d_skip.astype(x.dtype).reshape(G, hpg)[:, :, None]
    y = y.reshape(bsz, s, SSD_INNER)
    return rmsnorm(y * jax.nn.silu(z), norm_w)


def rel_bucket_band():
    W = WINDOW
    dist = np.arange(W)[:, None] - np.arange(2 * W)[None, :] + W
    n = np.maximum(dist, 0)
    max_exact = REL_BUCKETS // 2
    large = max_exact + (np.log(np.maximum(n, 1) / max_exact) / np.log(REL_MAX_DIST / max_exact)
                         * (REL_BUCKETS - max_exact)).astype(np.int32)
    large = np.minimum(large, REL_BUCKETS - 1)
    bucket = np.where(n < max_exact, n, large).astype(np.int32)
    valid = (dist >= 0) & (dist < W)
    return bucket, valid


def swa_attention(q, k, v, sinks, rel_table):
    bsz, s, _ = q.shape
    W, KV, Dh = WINDOW, ATT_KV_HEADS, ATT_HEAD_DIM
    G = ATT_Q_HEADS // KV
    nb = s // W
    q = q.reshape(bsz, nb, W, KV, G, Dh)
    k = k.reshape(bsz, nb, W, KV, Dh)
    v = v.reshape(bsz, nb, W, KV, Dh)
    pad = ((0, 0), (1, 0), (0, 0), (0, 0), (0, 0))
    kk = jnp.concatenate([jnp.pad(k, pad)[:, :-1], k], axis=2)
    vv = jnp.concatenate([jnp.pad(v, pad)[:, :-1], v], axis=2)
    scores = jnp.einsum('bnqhgd,bnkhd->bnhgqk', q, kk).astype(jnp.float32) / math.sqrt(Dh)
    bucket, valid = rel_bucket_band()
    bias = rel_table.astype(jnp.float32)[bucket]
    bias = jnp.transpose(bias, (2, 0, 1)).reshape(KV, G, W, 2 * W)
    first_ok = np.arange(2 * W) >= W
    mask = jnp.asarray(valid)[None] & ((jnp.arange(nb) > 0)[:, None, None] | jnp.asarray(first_ok)[None, None])
    scores = jnp.where(mask[None, :, None, None], scores + bias, -jnp.inf)
    sink = sinks.astype(jnp.float32).reshape(KV, G)[None, None, :, :, None, None]
    m = jnp.maximum(jnp.max(scores, axis=-1, keepdims=True), sink)
    p = jnp.exp(scores - m)
    p = p / (jnp.sum(p, axis=-1, keepdims=True) + jnp.exp(sink - m))
    out = jnp.einsum('bnhgqk,bnkhd->bnqhgd', p.astype(vv.dtype), vv)
    return out.reshape(bsz, s, ATT_WIDTH)


def chunk_sgu(u, gv, ln_w, ln_b, w_s, b_s):
    bsz, s, _ = u.shape
    C = GM_CHUNK
    nc = s // C
    u = jax.nn.gelu(u)
    gv = layernorm(jax.nn.gelu(gv), ln_w, ln_b).reshape(bsz, nc, C, GM_GROUPS, GM_GROUP_DIM)
    w = w_s * jnp.tril(jnp.ones((C, C), dtype=w_s.dtype))[None]
    mixed = jnp.einsum('gts,bcsgd->bctgd', w, gv) + jnp.transpose(b_s)[None, None, :, :, None]
    return u * mixed.reshape(bsz, s, GM_WIDTH)


def setup_inputs(seed: int = 0) -> dict:
    key = jax.random.key(seed)
    ks = jax.random.split(key, 32)

    def nrm(k, shape, scale):
        return jax.random.normal(k, shape, jnp.float32) * scale

    def gain(k, shape):
        return 1.0 + 0.02 * jax.random.normal(k, shape, jnp.float32)

    dt = jnp.exp(jax.random.uniform(ks[10], (DEPTH, SSD_HEADS), jnp.float32)
                 * (math.log(0.1) - math.log(0.001)) + math.log(0.001))
    return {
        "x": jax.random.normal(ks[0], (BATCH, SEQ, D_MODEL), jnp.float32),
        "ffn1_norm": gain(ks[1], (DEPTH, D_MODEL)),
        "ffn1_w_gate": nrm(ks[2], (DEPTH, D_MODEL, D_FF), D_MODEL ** -0.5),
        "ffn1_w_up": nrm(ks[3], (DEPTH, D_MODEL, D_FF), D_MODEL ** -0.5),
        "ffn1_w_down": nrm(ks[4], (DEPTH, D_FF, D_MODEL), D_FF ** -0.5),
        "mix_norm": gain(ks[5], (DEPTH, D_MODEL)),
        "w_in": nrm(ks[6], (DEPTH, D_MODEL, D_IN_PROJ), D_MODEL ** -0.5),
        "conv_w": nrm(ks[7], (DEPTH, SSD_CONV, SSD_XBC), SSD_CONV ** -0.5),
        "conv_b": nrm(ks[8], (DEPTH, SSD_XBC), 0.02),
        "dt_bias": dt + jnp.log(-jnp.expm1(-dt)),
        "a_log": jnp.log(jax.random.uniform(ks[11], (DEPTH, SSD_HEADS), jnp.float32, 1.0, 16.0)),
        "d_skip": gain(ks[12], (DEPTH, SSD_HEADS)),
        "ssd_norm": gain(ks[13], (DEPTH, SSD_INNER)),
        "attn_sinks": nrm(ks[14], (DEPTH, ATT_Q_HEADS), 0.5),
        "rel_bias": nrm(ks[15], (REL_BUCKETS, ATT_Q_HEADS), 0.5),
        "attn_out_norm": gain(ks[16], (DEPTH, ATT_WIDTH)),
        "sgu_ln_w": gain(ks[17], (DEPTH, GM_WIDTH)),
        "sgu_ln_b": nrm(ks[18], (DEPTH, GM_WIDTH), 0.02),
        "sgu_w": nrm(ks[19], (DEPTH, GM_GROUPS, GM_CHUNK, GM_CHUNK), GM_CHUNK ** -0.5),
        "sgu_b": 1.0 + nrm(ks[20], (DEPTH, GM_GROUPS, GM_CHUNK), 0.1),
        "sgu_out_norm": gain(ks[21], (DEPTH, GM_WIDTH)),
        "w_out": nrm(ks[22], (DEPTH, D_MIX, D_MODEL), D_MIX ** -0.5),
        "ffn2_norm": gain(ks[23], (DEPTH, D_MODEL)),
        "ffn2_w_gate": nrm(ks[24], (DEPTH, D_MODEL, D_FF), D_MODEL ** -0.5),
        "ffn2_w_up": nrm(ks[25], (DEPTH, D_MODEL, D_FF), D_MODEL ** -0.5),
        "ffn2_w_down": nrm(ks[26], (DEPTH, D_FF, D_MODEL), D_FF ** -0.5),
        "final_norm": gain(ks[27], (D_MODEL,)),
    }


def reference(x, ffn1_norm, ffn1_w_gate, ffn1_w_up, ffn1_w_down, mix_norm, w_in,
              conv_w, conv_b, dt_bias, a_log, d_skip, ssd_norm, attn_sinks, rel_bias,
              attn_out_norm, sgu_ln_w, sgu_ln_b, sgu_w, sgu_b, sgu_out_norm, w_out,
              ffn2_norm, ffn2_w_gate, ffn2_w_up, ffn2_w_down, final_norm):
    for l in range(DEPTH):
        x = x + 0.5 * swiglu(rmsnorm(x, ffn1_norm[l]), ffn1_w_gate[l], ffn1_w_up[l], ffn1_w_down[l])
        h = rmsnorm(x, mix_norm[l])
        proj = h @ w_in[l]
        y_ssd = ssd_mixer(proj[..., OFF_Z:OFF_XBC], proj[..., OFF_XBC:OFF_DT],
                          proj[..., OFF_DT:OFF_Q], conv_w[l], conv_b[l], dt_bias[l],
                          a_log[l], d_skip[l], ssd_norm[l])
        y_att = rmsnorm(swa_attention(proj[..., OFF_Q:OFF_K], proj[..., OFF_K:OFF_V],
                                      proj[..., OFF_V:OFF_U], attn_sinks[l], rel_bias),
                        attn_out_norm[l])
        y_sgu = rmsnorm(chunk_sgu(proj[..., OFF_U:OFF_GV], proj[..., OFF_GV:],
                                  sgu_ln_w[l], sgu_ln_b[l], sgu_w[l], sgu_b[l]),
                        sgu_out_norm[l])
        x = x + jnp.concatenate([y_ssd, y_att, y_sgu], axis=-1) @ w_out[l]
        x = x + 0.5 * swiglu(rmsnorm(x, ffn2_norm[l]), ffn2_w_gate[l], ffn2_w_up[l], ffn2_w_down[l])
    return rmsnorm(x, final_norm)
```

```cpp
#include <hip/hip_runtime.h>
#include <hip/hip_cooperative_groups.h>
#include <cstdio>
#include <cstdint>
namespace cg = cooperative_groups;
namespace pg8 {
#define PG8_LAS __attribute__((address_space(3)))
typedef unsigned short bf16_t;
typedef short bf16x8 __attribute__((ext_vector_type(8)));
typedef float f32x4 __attribute__((ext_vector_type(4)));
typedef unsigned u32x4 __attribute__((ext_vector_type(4)));
constexpr int BM = 256, BK = 64, HALF = 128, HTB = HALF * BK * 2  , STAGE_BYTES = 8 * HTB, NXCD = 8, WGM = 8;

__host__ __device__ __forceinline__ int lds_byte(int r, int c) { const int st = (r >> 4) * 2 + (c >> 5), rr = r & 15, cc = c & 31, ob = rr * 64 + cc * 2; return st * 1024 + (ob ^ (((ob >> 9) & 1) << 5)); }
__host__ __device__ __forceinline__ void stage_rc(int b, int& R, int& C) { const int st = b / 1024, sb = b % 1024, swz = sb ^ (((sb >> 9) & 1) << 5); R = (st >> 1) * 16 + swz / 64; C = (st & 1) * 32 + (swz % 64) / 2; }
__host__ __device__ __forceinline__ int perm32(int rho) { const int n = rho >> 4, i = rho & 15; return 8 * (i >> 2) + 4 * n + (i & 3); }

struct Unit { int pm, pn; };
struct Gemm { const bf16_t* A; const bf16_t* Bt; int M, N, K; };

struct StaticOrder {
    int nM, nN, nwg, G, c;
    __host__ __device__ void init(int M, int N, int G_, int c_) { nM = M / BM; nN = N / BM; nwg = nM * nN; G = G_; c = c_; }
    __host__ __device__ bool next(int i, Unit& u) const {
        const long L = (long)i * G + c; if (L >= nwg) return false;
        int wgid = (int)L; { const int q = nwg / NXCD, r = nwg % NXCD, xcd = wgid % NXCD, off = wgid / NXCD; wgid = (xcd < r ? xcd * (q + 1) : r * (q + 1) + (xcd - r) * q) + off; }
        const int nig = WGM * nN, gid = wgid / nig, fm = gid * WGM, gsz = (nM - fm) < WGM ? (nM - fm) : WGM;
        u.pm = fm + ((wgid % nig) % gsz); u.pn = (wgid % nig) / gsz; return true;
    }
    __device__ __forceinline__ void a_ready(const Unit&) const {}
    __device__ __forceinline__ void done(const Unit&) const {}
};

__device__ __forceinline__ unsigned cvt_pk_bf16(float lo, float hi) { unsigned r; asm volatile("v_cvt_pk_bf16_f32 %0, %1, %2" : "=v"(r) : "v"(lo), "v"(hi)); return r; }
typedef float f32x2 __attribute__((ext_vector_type(2)));
template <class Epi, class Sched, bool ALIGN_EPI = false, bool SP2 = false>
__device__ __forceinline__ void gemm_phase(PG8_LAS unsigned char* lds, const Gemm g, const Sched& S, const Epi& E) {
    int tid_; asm volatile("v_mov_b32 %0, %1" : "=v"(tid_) : "v"((int)threadIdx.x));
    const int tid = tid_, wid = __builtin_amdgcn_readfirstlane(tid >> 6), lane = tid & 63, wr = wid >> 2, wc = wid & 3, fr = lane & 15, fq = lane >> 4;
    const int K = g.K, nt = K / BK;
    unsigned voffA[2], voffB[2];
#pragma unroll
    for (int i = 0; i < 2; ++i) { int R, C; stage_rc(tid * 16 + i * 8192, R, C); const int Rb = Epi::PERM ? ((R & ~31) + perm32(R & 31)) : R;
        voffA[i] = (unsigned)(R * K + C) * 2u; voffB[i] = (unsigned)(Rb * K + C) * 2u; }
    const size_t kstep = (size_t)(BK * 2);
    const size_t hstep = (size_t)HALF * K * 2;
    const size_t tstep = 2 * hstep;
    const unsigned ldsw = (unsigned)wid * 1024u;
    const int aoff = lds_byte(wr * 64 + fr, fq * 8), boff = lds_byte(wc * 32 + fr, fq * 8);
#define PG8_SA(b, h) (((b) * 2 + (h)) * HTB)
#define PG8_SB(b, h) ((4 + (b) * 2 + (h)) * HTB)
#define PG8_STAGE(bufoff, gbase, voff) do { _Pragma("unroll") for (int _i = 0; _i < 2; ++_i) \
        __builtin_amdgcn_global_load_lds((const unsigned*)((const char*)(gbase) + (voff)[_i]), (PG8_LAS unsigned*)(lds + (bufoff) + ldsw + _i * 8192), 16, 0, 0); } while (0)
#define PG8_LDA(dst, b, h) do { _Pragma("unroll") for (int m = 0; m < 4; ++m) _Pragma("unroll") for (int k = 0; k < 2; ++k) dst[m][k] = *(const PG8_LAS bf16x8*)(lds + PG8_SA(b, h) + aoff + m * 2048 + k * 1024); } while (0)
#define PG8_LDB(dst, b, h) do { _Pragma("unroll") for (int n = 0; n < 2; ++n) _Pragma("unroll") for (int k = 0; k < 2; ++k) dst[n][k] = *(const PG8_LAS bf16x8*)(lds + PG8_SB(b, h) + boff + n * 2048 + k * 1024); } while (0)
#define PG8_MMA(ai, bj, At, Bt) do { __builtin_amdgcn_s_setprio(1); _Pragma("unroll") for (int m = 0; m < 4; ++m) _Pragma("unroll") for (int n = 0; n < 2; ++n) _Pragma("unroll") for (int k = 0; k < 2; ++k) \
        acc[ai][bj][m][n] = __builtin_amdgcn_mfma_f32_16x16x32_bf16(Bt[n][k], At[m][k], acc[ai][bj][m][n], 0, 0, 0); __builtin_amdgcn_s_setprio(0); } while (0)
#define PG8_WAIT_V(n) asm volatile("s_waitcnt vmcnt(" #n ")" ::: "memory")
#define PG8_WAIT_L(n) asm volatile("s_waitcnt lgkmcnt(" #n ")" ::: "memory")
#define PG8_BAR __builtin_amdgcn_s_barrier()
#define PG8_SCHED __builtin_amdgcn_sched_barrier(0)
    Unit cur, nxt; int ui = 0;
    if (!S.next(0, cur)) return;
    f32x4 acc[2][2][4][2];
#pragma unroll
    for (int a = 0; a < 2; ++a)
#pragma unroll
        for (int b = 0; b < 2; ++b)
#pragma unroll
            for (int m = 0; m < 4; ++m)
#pragma unroll
                for (int n = 0; n < 2; ++n) acc[a][b][m][n] = (f32x4){0.f, 0.f, 0.f, 0.f};
    bf16x8 At[4][2], B0[2][2], B1[2][2];
    const char* cA = (const char*)g.A + (size_t)cur.pm * tstep; const char* cB = (const char*)g.Bt + (size_t)cur.pn * tstep;
    S.a_ready(cur);
    if constexpr (SP2) {
        PG8_STAGE(PG8_SB(0, 0), cB, voffB); PG8_STAGE(PG8_SB(0, 1), cB + hstep, voffB); PG8_STAGE(PG8_SA(0, 0), cA, voffA); PG8_STAGE(PG8_SA(0, 1), cA + hstep, voffA);
        if (wr == 1) PG8_BAR;
        PG8_WAIT_V(2); PG8_BAR;
        PG8_STAGE(PG8_SB(1, 0), cB + kstep, voffB); PG8_STAGE(PG8_SA(1, 0), cA + kstep, voffA); PG8_STAGE(PG8_SB(1, 1), cB + hstep + kstep, voffB);
        PG8_WAIT_V(6); PG8_BAR;
    } else {
        PG8_STAGE(PG8_SB(0, 0), cB, voffB); PG8_STAGE(PG8_SA(0, 0), cA, voffA); PG8_STAGE(PG8_SB(0, 1), cB + hstep, voffB); PG8_STAGE(PG8_SA(0, 1), cA + hstep, voffA);
        if (wr == 1) PG8_BAR;
        PG8_WAIT_V(4); PG8_BAR;
        PG8_STAGE(PG8_SB(1, 0), cB + kstep, voffB); PG8_STAGE(PG8_SA(1, 0), cA + kstep, voffA); PG8_STAGE(PG8_SB(1, 1), cB + hstep + kstep, voffB);
        PG8_WAIT_V(6); PG8_BAR;
    }
    for (;;) {
        const bool has_next = S.next(ui + 1, nxt);
        const char* nA = has_next ? (const char*)g.A + (size_t)nxt.pm * tstep : cA; const char* nB = has_next ? (const char*)g.Bt + (size_t)nxt.pn * tstep : cB;
        for (int t = 0; t < nt; t += 2) {
            const bool last = (t == nt - 2);
            const char* a1 = cA + (size_t)(t + 1) * kstep;
            const char* a2 = last ? nA : cA + (size_t)(t + 2) * kstep; const char* b2 = last ? nB : cB + (size_t)(t + 2) * kstep;
            const char* a3 = a2 + kstep; const char* b3 = b2 + kstep;
            if (last && has_next) S.a_ready(nxt);
            if constexpr (SP2) {
            PG8_LDB(B0, 0, 0); PG8_LDB(B1, 0, 1); PG8_SCHED; PG8_LDA(At, 0, 0); PG8_STAGE(PG8_SA(1, 1), a1 + hstep, voffA);
            PG8_WAIT_V(8); PG8_WAIT_L(0); PG8_BAR; PG8_MMA(0, 0, At, B0); PG8_MMA(0, 1, At, B1); PG8_BAR; PG8_SCHED;
            PG8_LDA(At, 0, 1); PG8_STAGE(PG8_SB(0, 0), b2, voffB); PG8_STAGE(PG8_SB(0, 1), b2 + hstep, voffB); PG8_STAGE(PG8_SA(0, 0), a2, voffA);
            PG8_WAIT_V(8); PG8_WAIT_L(0); PG8_BAR; PG8_MMA(1, 0, At, B0); PG8_MMA(1, 1, At, B1); PG8_BAR; PG8_SCHED;
            PG8_LDB(B0, 1, 0); PG8_LDB(B1, 1, 1); PG8_SCHED; PG8_LDA(At, 1, 0); PG8_STAGE(PG8_SA(0, 1), a2 + hstep, voffA);
            PG8_WAIT_V(8); PG8_WAIT_L(0); PG8_BAR; PG8_MMA(0, 0, At, B0); PG8_MMA(0, 1, At, B1); PG8_BAR; PG8_SCHED;
            PG8_LDA(At, 1, 1); PG8_STAGE(PG8_SB(1, 0), b3, voffB); PG8_STAGE(PG8_SB(1, 1), b3 + hstep, voffB); PG8_STAGE(PG8_SA(1, 0), a3, voffA);
            PG8_WAIT_V(8); PG8_WAIT_L(0); PG8_BAR; PG8_MMA(1, 0, At, B0); PG8_MMA(1, 1, At, B1); PG8_BAR; PG8_SCHED;
            } else {
            PG8_LDB(B0, 0, 0); PG8_SCHED; PG8_LDA(At, 0, 0); PG8_STAGE(PG8_SA(1, 1), a1 + hstep, voffA);
            PG8_WAIT_L(8); PG8_BAR; PG8_WAIT_L(0); PG8_MMA(0, 0, At, B0); PG8_BAR; PG8_SCHED;
            PG8_LDB(B1, 0, 1); PG8_STAGE(PG8_SB(0, 0), b2, voffB);
            PG8_BAR; PG8_WAIT_L(0); PG8_MMA(0, 1, At, B1); PG8_BAR;
            PG8_LDA(At, 0, 1); PG8_STAGE(PG8_SA(0, 0), a2, voffA);
            PG8_BAR; PG8_WAIT_L(0); PG8_MMA(1, 0, At, B0); PG8_BAR; PG8_SCHED;
            PG8_STAGE(PG8_SB(0, 1), b2 + hstep, voffB);
            PG8_WAIT_V(6); PG8_BAR; PG8_MMA(1, 1, At, B1); PG8_BAR;
            PG8_LDB(B0, 1, 0); PG8_SCHED; PG8_LDA(At, 1, 0); PG8_STAGE(PG8_SA(0, 1), a2 + hstep, voffA);
            PG8_WAIT_L(8); PG8_BAR; PG8_WAIT_L(0); PG8_MMA(0, 0, At, B0); PG8_BAR; PG8_SCHED;
            PG8_LDB(B1, 1, 1); PG8_STAGE(PG8_SB(1, 0), b3, voffB);
            PG8_BAR; PG8_WAIT_L(0); PG8_MMA(0, 1, At, B1); PG8_BAR;
            PG8_LDA(At, 1, 1); PG8_STAGE(PG8_SA(1, 0), a3, voffA);
            PG8_BAR; PG8_WAIT_L(0); PG8_MMA(1, 0, At, B0); PG8_BAR; PG8_SCHED;
            PG8_STAGE(PG8_SB(1, 1), b3 + hstep, voffB);
            PG8_WAIT_V(6); PG8_BAR; PG8_MMA(1, 1, At, B1); PG8_BAR;
            }
        }
        if constexpr (ALIGN_EPI) { if (wr == 0) PG8_BAR; }
        if constexpr (!Epi::AFTER_DRAIN) { E(acc, cur, wr, wc, fr, fq); S.done(cur); }
        if (!has_next) break;
#pragma unroll
        for (int a = 0; a < 2; ++a)
#pragma unroll
            for (int b = 0; b < 2; ++b)
#pragma unroll
                for (int m = 0; m < 4; ++m)
#pragma unroll
                    for (int n = 0; n < 2; ++n) acc[a][b][m][n] = (f32x4){0.f, 0.f, 0.f, 0.f};
        cur = nxt; cA = nA; cB = nB; ++ui;
        if constexpr (ALIGN_EPI) { if (wr == 1) PG8_BAR; }
    }
    PG8_WAIT_V(0);
    if constexpr (!ALIGN_EPI) { if (wr == 0) PG8_BAR; }
    PG8_BAR;
    if constexpr (Epi::AFTER_DRAIN) { E.fused(acc, cur, wr, wc, fr, fq, lds, wid, lane); S.done(cur); }
#undef PG8_SA
#undef PG8_SB
#undef PG8_STAGE
#undef PG8_LDA
#undef PG8_LDB
#undef PG8_MMA
#undef PG8_WAIT_V
#undef PG8_WAIT_L
#undef PG8_BAR
#undef PG8_SCHED
}
}

#define LAS __attribute__((address_space(3)))
#define DI __device__ __forceinline__
typedef unsigned short bf16;
typedef short bf16x8 __attribute__((ext_vector_type(8)));
typedef float f32x4 __attribute__((ext_vector_type(4)));
typedef unsigned u32x4 __attribute__((ext_vector_type(4)));
typedef unsigned u32x2 __attribute__((ext_vector_type(2)));

constexpr int BATCH = 8, SEQ = 4096, DM = 1024, MTOK = BATCH * SEQ, DFF = 2816, DEPTH = 2;
constexpr int NGU = 2 * DFF;
constexpr int NPROJ = 2816;
constexpr int DINP = 2568;
constexpr int PC_Z = 0, PC_XBC = 512, PC_Q = 1536, PC_K = 1792, PC_V = 1920, PC_U = 2048, PC_GV = 2304, PC_DT = 2560;
constexpr int NCH = 32;
constexpr float EPS = 1e-6f;
constexpr size_t MiB = 1u << 20;
constexpr size_t WS_BAR = 65536, WS_CD = 0, WS_SSQ = 89 * MiB, WS_MSSQ = 3 * MiB, WS_DTRAW = 5 * MiB, WS_SGUW = 6 * MiB, WS_W = 8 * MiB;
constexpr size_t WL_GU1 = 0, WL_D1 = 11 * MiB, WL_IN = WL_D1 + 5632 * 1024, WL_OUT = WL_IN + 5632 * 1024, WL_GU2 = WL_OUT + 2 * MiB, WL_D2 = WL_GU2 + 11 * MiB, WL_SIZE = WL_D2 + 5632 * 1024;
constexpr size_t WS_XB = 96 * MiB, WS_ST = 96 * MiB, WS_ACT = 160 * MiB, WS_YG = 160 * MiB, WS_YCAT = 224 * MiB, WS_PV = 288 * MiB, WS_PROJ = 336 * MiB, WS_END = 512 * MiB;
static_assert(WS_W + 2 * WL_SIZE <= WS_XB, "weights fit");
constexpr int LDS_BYTES = 147456;
#ifndef PH
#define PH 2047
#endif

__device__ const unsigned char T5_BUCKET[128] = {0,1,2,3,4,5,6,7,8,9,10,11,12,13,14,15,16,16,16,17,17,18,18,18,19,19,19,20,20,20,20,21,21,21,21,22,22,22,22,22,23,23,23,23,23,23,24,24,24,24,24,24,25,25,25,25,25,25,25,26,26,26,26,26,26,26,26,27,27,27,27,27,27,27,27,27,27,28,28,28,28,28,28,28,28,28,28,29,29,29,29,29,29,29,29,29,29,29,29,30,30,30,30,30,30,30,30,30,30,30,30,30,30,31,31,31,31,31,31,31,31,31,31,31,31,31,31,31};

DI float bf2f(unsigned short b) { return __uint_as_float((unsigned)b << 16); }
typedef float f32x2_t __attribute__((ext_vector_type(2)));
typedef __bf16 bf16x2_t __attribute__((ext_vector_type(2)));
DI unsigned pk2(float lo, float hi) { const f32x2_t v = {lo, hi}; const bf16x2_t b = __builtin_convertvector(v, bf16x2_t); return __builtin_bit_cast(unsigned, b); }
DI unsigned short f2bf(float f) { return (unsigned short)(pk2(f, 0.f) & 0xffffu); }
DI void unpack8(u32x4 r, float (&v)[8]) {
    v[0] = __uint_as_float(r.x << 16); v[1] = __uint_as_float(r.x & 0xffff0000u); v[2] = __uint_as_float(r.y << 16); v[3] = __uint_as_float(r.y & 0xffff0000u);
    v[4] = __uint_as_float(r.z << 16); v[5] = __uint_as_float(r.z & 0xffff0000u); v[6] = __uint_as_float(r.w << 16); v[7] = __uint_as_float(r.w & 0xffff0000u);
}
DI u32x4 pack8(const float (&v)[8]) { u32x4 r; r.x = pk2(v[0], v[1]); r.y = pk2(v[2], v[3]); r.z = pk2(v[4], v[5]); r.w = pk2(v[6], v[7]); return r; }
DI float fast_sigmoid(float x) { return __builtin_amdgcn_rcpf(1.f + __builtin_amdgcn_exp2f(-1.4426950409f * x)); }
DI float silu_f(float x) { return x * fast_sigmoid(x); }
DI float gelu_f(float x) { const float u = 1.5957691216f * (x + 0.044715f * x * x * x); return x * fast_sigmoid(u); }
DI int opaque_tid() { int t; asm volatile("v_mov_b32 %0, %1" : "=v"(t) : "v"((int)threadIdx.x)); return t; }
#define PHASE_IDS() const int tid = opaque_tid(), lane = tid & 63, r16 = lane & 15, q4 = lane >> 4; (void)r16; (void)q4; (void)tid
DI float wave_sum(float v) {
#pragma unroll
    for (int o = 1; o < 64; o <<= 1) v += __shfl_xor(v, o);
    return v;
}
DI float sum16(float v) { v += __shfl_xor(v, 1); v += __shfl_xor(v, 2); v += __shfl_xor(v, 4); v += __shfl_xor(v, 8); return v; }
DI float max16(float v) { v = fmaxf(v, __shfl_xor(v, 1)); v = fmaxf(v, __shfl_xor(v, 2)); v = fmaxf(v, __shfl_xor(v, 4)); v = fmaxf(v, __shfl_xor(v, 8)); return v; }
DI f32x4 mfma16(bf16x8 a, bf16x8 b, f32x4 c) { return __builtin_amdgcn_mfma_f32_16x16x32_bf16(a, b, c, 0, 0, 0); }
DI bf16x8 lds_frag(const LAS bf16* base, int row, int stride, int k) { return *(const LAS bf16x8*)(base + row * stride + k); }
DI float rstd4(f32x4 p) { return rsqrtf(((p.x + p.y) + (p.z + p.w)) * (1.f / DM) + EPS); }
DI float row_rstd(const float* ssq, unsigned row) { return rstd4(*(const f32x4*)(ssq + row * 4u)); }

using pg8::Unit;
struct EpiSwiglu {
    static constexpr bool PERM = true, AFTER_DRAIN = false;
    bf16* O; const float* ssq;
    DI void operator()(const f32x4 (&acc)[2][2][4][2], const Unit& u, int wr, int wc, int fr, int fq) const {
        const unsigned row0 = u.pm * 256 + wr * 64 + fr; const unsigned col0 = u.pn * 128 + wc * 32 + 8 * fq;
        float rs8[8];
        {
            f32x4 p8[8];
#pragma unroll
            for (int k = 0; k < 8; ++k) p8[k] = *(const f32x4*)(ssq + (row0 + (k >> 2) * 128 + (k & 3) * 16) * 4u);
#pragma unroll
            for (int k = 0; k < 8; ++k) rs8[k] = rstd4(p8[k]);
        }
        unsigned row = row0;
#pragma unroll
        for (int ai = 0; ai < 2; ++ai) {
#pragma unroll
            for (int m = 0; m < 4; ++m) {
                const float rs = rs8[ai * 4 + m];
                float h[8];
#pragma unroll
                for (int n = 0; n < 2; ++n)
#pragma unroll
                    for (int i = 0; i < 4; ++i) { const float g = acc[ai][0][m][n][i] * rs, uu = acc[ai][1][m][n][i] * rs; h[n * 4 + i] = g * uu * fast_sigmoid(g); }
                *(u32x4*)(O + (row * (unsigned)DFF + col0)) = pack8(h);
                asm volatile("" : "+v"(row));
                row += 16;
            }
            row += 64;
        }
    }
};
struct EpiResid {
    static constexpr bool PERM = true, AFTER_DRAIN = false;
    bf16* xb; float* ssq; float alpha; LAS float* red;
    DI void operator()(const f32x4 (&acc)[2][2][4][2], const Unit& u, int wr, int wc, int fr, int fq) const {
        unsigned row = u.pm * 256 + wr * 64 + fr; const unsigned col0 = u.pn * 256 + wc * 32 + 8 * fq;
#pragma unroll
        for (int ai = 0; ai < 2; ++ai) {
            u32x4 bv[4][2];
#pragma unroll
            for (int m = 0; m < 4; ++m)
#pragma unroll
                for (int bj = 0; bj < 2; ++bj) bv[m][bj] = *(const u32x4*)(xb + ((row + 16 * m) * (unsigned)DM + col0 + bj * 128));
#pragma unroll
            for (int m = 0; m < 4; ++m) {
                float ss = 0.f; const unsigned off0 = row * (unsigned)DM + col0;
#pragma unroll
                for (int bj = 0; bj < 2; ++bj) {
                    float o[8]; unpack8(bv[m][bj], o);
#pragma unroll
                    for (int n = 0; n < 2; ++n)
#pragma unroll
                        for (int i = 0; i < 4; ++i) { o[n * 4 + i] += acc[ai][bj][m][n][i] * alpha; ss += o[n * 4 + i] * o[n * 4 + i]; }
                    *(u32x4*)(xb + (off0 + bj * 128)) = pack8(o);
                }
                ss += __shfl_xor(ss, 16); ss += __shfl_xor(ss, 32);
                if (fq == 0) red[(ai * 128 + wr * 64 + m * 16 + fr) * 4 + wc] = ss;
                asm volatile("" : "+v"(row));
                row += 16;
            }
            asm volatile("" ::: "memory");
            row += 64;
        }
        asm volatile("s_waitcnt lgkmcnt(0)" ::: "memory"); __builtin_amdgcn_s_barrier(); asm volatile("" ::: "memory");
        const int t = (wr * 4 + wc) * 64 + fq * 16 + fr;
        if (t < 256) { const f32x4 p = *(const LAS f32x4*)(red + t * 4); ssq[(u.pm * 256 + t) * 4u + u.pn] = (p.x + p.y) + (p.z + p.w); }
    }
};
struct EpiProj {
    static constexpr bool PERM = true, AFTER_DRAIN = false;
    bf16* O; const float* ssq;
    DI void operator()(const f32x4 (&acc)[2][2][4][2], const Unit& u, int wr, int wc, int fr, int fq) const {
        const unsigned row0 = u.pm * 256 + wr * 64 + fr; const unsigned col0 = u.pn * 256 + wc * 32 + 8 * fq;
        float rs8[8];
        {
            f32x4 p8[8];
#pragma unroll
            for (int k = 0; k < 8; ++k) p8[k] = *(const f32x4*)(ssq + (row0 + (k >> 2) * 128 + (k & 3) * 16) * 4u);
#pragma unroll
            for (int k = 0; k < 8; ++k) rs8[k] = rstd4(p8[k]);
        }
        unsigned row = row0;
#pragma unroll
        for (int ai = 0; ai < 2; ++ai) {
#pragma unroll
            for (int m = 0; m < 4; ++m) {
                const float rs = rs8[ai * 4 + m];
#pragma unroll
                for (int bj = 0; bj < 2; ++bj) {
                    float h[8];
#pragma unroll
                    for (int n = 0; n < 2; ++n)
#pragma unroll
                        for (int i = 0; i < 4; ++i) h[n * 4 + i] = acc[ai][bj][m][n][i] * rs;
                    *(u32x4*)(O + (row * (unsigned)NPROJ + col0 + bj * 128)) = pack8(h);
                }
                asm volatile("" : "+v"(row));
                row += 16;
            }
            row += 64;
        }
    }
};

DI const float* src_col(int kind, const float* g, const float* u, int n) {
    if (kind == 0) return g + n;
    if (kind == 1) { const int t = n >> 8, w = n & 255; return (w < 128) ? g + 128 * t + w : u + 128 * t + (w - 128); }
    if (n < 1536) return g + n;
    if (n < 2560) return g + n + 8;
    if (n < 2568) return g + 1536 + (n - 2560);
    return nullptr;
}
DI void transpose_item(int kind, const float* g, const float* u, int ldn, int K, int Np, const float* kscale, bf16* WT, LAS float* scr, int item, int lane) {
    const int nblk = Np / 32, kb = item / nblk, nb = item % nblk, k0 = 64 * kb, n0 = 32 * nb;
    const float* colp = src_col(kind, g, u, n0 + (lane & 31));
    float v[32];
    if (colp) {
        const float* p = colp + (size_t)(k0 + (lane >> 5)) * ldn;
#pragma unroll
        for (int i = 0; i < 32; ++i) v[i] = p[(size_t)(2 * i) * ldn];
    } else {
#pragma unroll
        for (int i = 0; i < 32; ++i) v[i] = 0.f;
    }
#pragma unroll
    for (int i = 0; i < 32; ++i) scr[(2 * i + (lane >> 5)) * 33 + (lane & 31)] = v[i];
    asm volatile("s_waitcnt lgkmcnt(0)" ::: "memory");
    const int c = lane & 7;
    float ks[8];
    if (kscale) { const f32x4 a = *(const f32x4*)(kscale + k0 + 8 * c), b2 = *(const f32x4*)(kscale + k0 + 8 * c + 4); ks[0] = a.x; ks[1] = a.y; ks[2] = a.z; ks[3] = a.w; ks[4] = b2.x; ks[5] = b2.y; ks[6] = b2.z; ks[7] = b2.w; }
    else {
#pragma unroll
        for (int i = 0; i < 8; ++i) ks[i] = 1.f;
    }
#pragma unroll
    for (int j = 0; j < 4; ++j) { const int n = (lane >> 3) + 8 * j; const LAS float* sp = scr + (8 * c) * 33 + n;
        u32x4 o; o.x = pk2(sp[0 * 33] * ks[0], sp[1 * 33] * ks[1]); o.y = pk2(sp[2 * 33] * ks[2], sp[3 * 33] * ks[3]); o.z = pk2(sp[4 * 33] * ks[4], sp[5 * 33] * ks[5]); o.w = pk2(sp[6 * 33] * ks[6], sp[7 * 33] * ks[7]);
        *(u32x4*)(WT + (size_t)(n0 + n) * K + k0 + 8 * c) = o; }
    asm volatile("s_waitcnt lgkmcnt(0)" ::: "memory");
}

DI void conv_load(u32x4 (&Rraw)[19], f32x4 (&Rw)[8], f32x4 (&Rb)[2], const bf16* __restrict__ proj, const float* __restrict__ cw, const float* __restrict__ cb, int pcol, size_t grow0, int c, int l0) {
    const int ch = pcol - PC_XBC;
    const bf16* p = proj + grow0 * NPROJ + pcol;
#pragma unroll
    for (int r = 0; r < 19; ++r) { const int l = l0 - 3 + r; Rraw[r] = (c == 0 && l < 0) ? (u32x4){0u, 0u, 0u, 0u} : *(const u32x4*)(p + (long)l * NPROJ); }
#pragma unroll
    for (int j = 0; j < 4; ++j) { Rw[2 * j] = *(const f32x4*)(cw + j * 1024 + ch); Rw[2 * j + 1] = *(const f32x4*)(cw + j * 1024 + ch + 4); }
    Rb[0] = *(const f32x4*)(cb + ch); Rb[1] = *(const f32x4*)(cb + ch + 4);
}
template <class F>
DI void conv_apply(const u32x4 (&Rraw)[19], const f32x4 (&Rw)[8], const f32x4 (&Rb)[2], int l0, F f) {
    float w[4][8], bias[8];
#pragma unroll
    for (int j = 0; j < 4; ++j)
#pragma unroll
        for (int i = 0; i < 4; ++i) { w[j][i] = Rw[2 * j][i]; w[j][4 + i] = Rw[2 * j + 1][i]; }
#pragma unroll
    for (int i = 0; i < 4; ++i) { bias[i] = Rb[0][i]; bias[4 + i] = Rb[1][i]; }
    float x0[8], x1[8], x2[8], x3[8];
    unpack8(Rraw[0], x0); unpack8(Rraw[1], x1); unpack8(Rraw[2], x2);
#pragma unroll
    for (int r = 0; r < 16; ++r) {
        unpack8(Rraw[r + 3], x3);
        float o[8];
#pragma unroll
        for (int i = 0; i < 8; ++i) { const float y = bias[i] + w[0][i] * x0[i] + w[1][i] * x1[i] + w[2][i] * x2[i] + w[3][i] * x3[i]; o[i] = silu_f(y); }
        f(l0 + r, o);
#pragma unroll
        for (int i = 0; i < 8; ++i) { x0[i] = x1[i]; x1[i] = x2[i]; x2[i] = x3[i]; }
        __builtin_amdgcn_sched_barrier(0);
    }
}

DI void ssd_dt_acs_wave(float x0, float x1, float negA, LAS float* s_dt, LAS float* s_acs, int lane) {
    const float d0 = (x0 > 20.f) ? x0 : log1pf(__expf(x0)), d1 = (x1 > 20.f) ? x1 : log1pf(__expf(x1));
    const float a0 = d0 * negA, a1 = d1 * negA;
    float sc = a0 + a1;
#pragma unroll
    for (int o = 1; o < 64; o <<= 1) { const float t = __shfl_up(sc, o); if (lane >= o) sc += t; }
    s_dt[2 * lane] = d0; s_dt[2 * lane + 1] = d1; s_acs[2 * lane] = sc - a1; s_acs[2 * lane + 1] = sc;
}

#define XB_TMO      128
#define XB_XCNT(j)  (256  + 64 * (j))
#define XB_XSUB(j)  (1280 + 64 * (j))
#define XB_XGEN(j)  (2304 + 64 * (j))
#define XB_TOP      3328
#define XB_TOPGEN   3392
#define XCD_BAR_WORDS 3456
#define XB_SPIN_CAP (1u << 18)

__device__ __forceinline__ unsigned xb_ld(unsigned* p)              { return __hip_atomic_load(p, __ATOMIC_RELAXED, __HIP_MEMORY_SCOPE_AGENT); }
__device__ __forceinline__ unsigned xb_add(unsigned* p, unsigned v) { return __hip_atomic_fetch_add(p, v, __ATOMIC_RELAXED, __HIP_MEMORY_SCOPE_AGENT); }
__device__ __forceinline__ unsigned xb_xcc_id() { return (unsigned)__builtin_amdgcn_s_getreg((3 << 11) | 20) & 0xFu; }
#define XB_SPIN(cond, bar) do { unsigned _sp = 0; while (cond) { __builtin_amdgcn_s_sleep(1); \
    if ((++_sp & 255u) == 0u) { if (xb_ld(&(bar)[XB_TMO])) break; if (_sp > XB_SPIN_CAP) { atomicAdd(&(bar)[XB_TMO], 1u); break; } } } } while (0)

struct XcdBarrier {
    unsigned* bar; unsigned x;
    volatile LAS unsigned* st;
};

__device__ __forceinline__ XcdBarrier xcd_barrier_post(unsigned* bar, volatile LAS unsigned* st) {
    XcdBarrier b; b.bar = bar; b.x = xb_xcc_id(); b.st = st;
    if (threadIdx.x == 0) (void)xb_add(&bar[XB_XCNT(b.x)], 1u);
    return b;
}
__device__ __forceinline__ void xcd_barrier_complete(unsigned* bar, unsigned x, unsigned& nloc, unsigned& nx) {
    const unsigned G = gridDim.x * gridDim.y * gridDim.z;
    unsigned sum, cnt, mine, sp = 0u;
    for (;;) {
        sum = 0u; cnt = 0u; mine = 0u;
#pragma unroll
        for (unsigned j = 0; j < 16; ++j) { const unsigned c = xb_ld(&bar[XB_XCNT(j)]); sum += c; cnt += (c > 0u) ? 1u : 0u; mine = (j == x) ? c : mine; }
        if (sum == G) break;
        __builtin_amdgcn_s_sleep(1);
        if ((++sp & 255u) == 0u) { if (xb_ld(&bar[XB_TMO])) break; if (sp > XB_SPIN_CAP) { atomicAdd(&bar[XB_TMO], 1u); break; } }
    }
    nloc = mine > 0u ? mine : 1u; nx = cnt > 0u ? cnt : 1u;
}

__device__ __forceinline__ void xcd_barrier(const XcdBarrier& b) {
    asm volatile("s_waitcnt vmcnt(0)" ::: "memory");
    __syncthreads();
    if (threadIdx.x == 0) {
        unsigned* bar = b.bar;
        __builtin_amdgcn_s_waitcnt(0);
        unsigned nloc = b.st[0], nx = b.st[1];
        if (nloc == 0u) { xcd_barrier_complete(bar, b.x, nloc, nx); b.st[0] = nloc; b.st[1] = nx; }
        const unsigned old = xb_add(&bar[XB_XSUB(b.x)], 1u);
        const unsigned gen = old / nloc;
        if (old + 1u == (gen + 1u) * nloc) {
            __builtin_amdgcn_fence(__ATOMIC_RELEASE, "agent");
            asm volatile("s_waitcnt vmcnt(0)" ::: "memory");
            const unsigned og = xb_add(&bar[XB_TOP], 1u);
            const unsigned tg = og / nx;
            if (og + 1u == (tg + 1u) * nx) xb_add(&bar[XB_TOPGEN], 1u);
            else XB_SPIN(xb_ld(&bar[XB_TOPGEN]) == tg, bar);
            __builtin_amdgcn_fence(__ATOMIC_ACQUIRE, "agent");
            xb_add(&bar[XB_XGEN(b.x)], 1u);
            asm volatile("s_waitcnt vmcnt(0)" ::: "memory");
        } else {
            XB_SPIN(xb_ld(&bar[XB_XGEN(b.x)]) == gen, bar);
            __builtin_amdgcn_fence(__ATOMIC_ACQUIRE, "agent");
            asm volatile("s_waitcnt vmcnt(0)" ::: "memory");
        }
    }
    __syncthreads();
}

struct Args { const float* in[27]; float* out; unsigned char* ws; };

__global__ void __launch_bounds__(512, 2) fwd_megakernel(Args args) {
    extern __shared__ __attribute__((aligned(16))) unsigned char lds_raw[];
    LAS unsigned char* lds = (LAS unsigned char*)lds_raw;
    cg::grid_group grid = cg::this_grid();
    if (args.ws == nullptr) grid.sync();
    volatile LAS unsigned* bst = (volatile LAS unsigned*)(lds + 147440);
    if (threadIdx.x < 4) bst[threadIdx.x] = 0u;
    __syncthreads();
    (void)xcd_barrier_post((unsigned*)(args.ws + WS_BAR), bst);
#define GRID_SYNC() do { XcdBarrier b_; b_.bar = (unsigned*)(args.ws + WS_BAR); b_.x = xb_xcc_id(); b_.st = (volatile LAS unsigned*)(lds + 147440); xcd_barrier(b_); } while (0)
    const int wave = __builtin_amdgcn_readfirstlane((int)threadIdx.x >> 6);
    const int G = gridDim.x, bid = blockIdx.x;
    const int gw = bid * 8 + wave, NGW = G * 8;
    const bool xsw = (G == 256);
    unsigned char* ws = args.ws;
    float* ssq = (float*)(ws + WS_SSQ);     float* mss_g = (float*)(ws + WS_MSSQ);   float* mss_a = mss_g + (size_t)2 * MTOK * 4;   float* dtraw = (float*)(ws + WS_DTRAW); float* CD = (float*)(ws + WS_CD);
    bf16* sguW = (bf16*)(ws + WS_SGUW);
    bf16* xb = (bf16*)(ws + WS_XB); float* ST = args.out;     bf16* actb = (bf16*)(ws + WS_ACT); bf16* Yg = (bf16*)(ws + WS_YG); bf16* ycat = (bf16*)(ws + WS_YCAT);
    bf16* PV = (bf16*)(ws + WS_PV); bf16* proj = (bf16*)(ws + WS_PROJ);

#if PH & 1
#ifndef PROREP
#define PROREP 1
#endif
#ifndef SYNCREP
#define SYNCREP 0
#endif
    for (int rep_ = 0; rep_ < SYNCREP; ++rep_) GRID_SYNC();
    for (int rep_ = 0; rep_ < PROREP; ++rep_) {
        PHASE_IDS();
        LAS float* scr = (LAS float*)(lds + wave * 16384);
        for (int mi = 0; mi < 12; ++mi) {
            const int l = mi / 6, t = mi % 6;
            const float* g; const float* u = nullptr; const float* ks = nullptr; int kind = 0, ldn, K, Np; bf16* WT = (bf16*)(ws + WS_W + (size_t)l * WL_SIZE);
            if (t == 0)      { g = args.in[2] + (size_t)l * DM * DFF; u = args.in[3] + (size_t)l * DM * DFF; ks = args.in[1] + l * DM; kind = 1; ldn = DFF; K = DM; Np = NGU; WT += WL_GU1 / 2; }
            else if (t == 1) { g = args.in[4] + (size_t)l * DFF * DM; ldn = DM; K = DFF; Np = DM; WT += WL_D1 / 2; }
            else if (t == 2) { g = args.in[6] + (size_t)l * DM * DINP; ks = args.in[5] + l * DM; kind = 2; ldn = DINP; K = DM; Np = NPROJ; WT += WL_IN / 2; }
            else if (t == 3) { g = args.in[21] + (size_t)l * DM * DM; ldn = DM; K = DM; Np = DM; WT += WL_OUT / 2; }
            else if (t == 4) { g = args.in[23] + (size_t)l * DM * DFF; u = args.in[24] + (size_t)l * DM * DFF; ks = args.in[22] + l * DM; kind = 1; ldn = DFF; K = DM; Np = NGU; WT += WL_GU2 / 2; }
            else             { g = args.in[25] + (size_t)l * DFF * DM; ldn = DM; K = DFF; Np = DM; WT += WL_D2 / 2; }
            const int nitems = (K / 64) * (Np / 32);
            for (int it = gw; it < nitems; it += NGW) transpose_item(kind, g, u, ldn, K, Np, ks, WT, scr, it, lane);
        }
        for (int i = bid * 512 + tid; i < DEPTH * 4 * 128 * 128; i += G * 512) { const int t = (i >> 7) & 127, s = i & 127; sguW[i] = f2bf(s <= t ? args.in[18][i] : 0.f); }
        const float* x = args.in[0];
        for (int m0 = gw; m0 < MTOK; m0 += 4 * NGW) {
            f32x4 v[4][4];
#pragma unroll
            for (int r = 0; r < 4; ++r) { const int m = min(m0 + r * NGW, MTOK - 1); const f32x4* xr = (const f32x4*)(x + (size_t)m * DM) + 2 * lane;
#pragma unroll
                for (int j = 0; j < 2; ++j) { v[r][2 * j] = xr[128 * j]; v[r][2 * j + 1] = xr[128 * j + 1]; } }
#pragma unroll
            for (int r = 0; r < 4; ++r) { const int m = m0 + r * NGW; if (m < MTOK) {
                float sq = 0.f; u32x4* o16 = (u32x4*)(xb + (size_t)m * DM) + lane;
#pragma unroll
                for (int j = 0; j < 2; ++j) { const f32x4 t = v[r][2 * j], t2 = v[r][2 * j + 1];
                    sq += ((t.x * t.x + t.y * t.y) + (t.z * t.z + t.w * t.w)) + ((t2.x * t2.x + t2.y * t2.y) + (t2.z * t2.z + t2.w * t2.w));
                    u32x4 w; w.x = pk2(t.x, t.y); w.y = pk2(t.z, t.w); w.z = pk2(t2.x, t2.y); w.w = pk2(t2.z, t2.w); o16[64 * j] = w; }
                sq = wave_sum(sq);
                if (lane == 0) *(f32x4*)(ssq + (size_t)m * 4) = (f32x4){sq, 0.f, 0.f, 0.f}; } }
        }
    }
#endif
    GRID_SYNC();

    for (int layer = 0; layer < DEPTH; ++layer) {
        const bf16* Wl = (const bf16*)(ws + WS_W + (size_t)layer * WL_SIZE);
        for (int half = 0; half < 2; ++half) {
#if PH & 2
#ifndef UPREP
#define UPREP 1
#endif
            for (int rep_ = 0; rep_ < UPREP; ++rep_) {
                pg8::Gemm g{xb, Wl + (half ? WL_GU2 : WL_GU1) / 2, MTOK, NGU, DM}; pg8::StaticOrder S; S.init(MTOK, NGU, G, bid);
                EpiSwiglu E{actb, ssq + (size_t)(3 * layer + 2 * half) * MTOK * 4};
                pg8::gemm_phase<EpiSwiglu, pg8::StaticOrder, true, true>(lds, g, S, E);
            }
            GRID_SYNC();
            {
                pg8::Gemm g{actb, Wl + (half ? WL_D2 : WL_D1) / 2, MTOK, DM, DFF}; pg8::StaticOrder S; S.init(MTOK, DM, G, bid);
                EpiResid E{xb, ssq + (size_t)(3 * layer + 2 * half + 1) * MTOK * 4, 0.5f, (LAS float*)(lds + 131072)};
                pg8::gemm_phase<EpiResid, pg8::StaticOrder, true, true>(lds, g, S, E);
            }
            GRID_SYNC();
            if (half == 1) break;

#endif
#if PH & 4
            {
                pg8::Gemm g{xb, Wl + WL_IN / 2, MTOK, 2560, DM}; pg8::StaticOrder S; S.init(MTOK, 2560, G, bid);
                EpiProj E{proj, ssq + (size_t)(3 * layer + 1) * MTOK * 4};
                pg8::gemm_phase<EpiProj, pg8::StaticOrder, true, true>(lds, g, S, E);
            }
            {
                PHASE_IDS();
                const float* ssq_in = ssq + (size_t)(3 * layer + 1) * MTOK * 4;
                const bf16* wdt = Wl + WL_IN / 2 + (size_t)(2560 + r16) * DM + q4 * 8;
                for (int rb = gw; rb < MTOK / 16; rb += NGW) {
                    const bf16* xa = xb + (size_t)(rb * 16 + r16) * DM + q4 * 8;
                    f32x4 acc = (f32x4){0.f, 0.f, 0.f, 0.f};
#pragma unroll 8
                    for (int ks = 0; ks < 32; ++ks) acc = mfma16(*(const bf16x8*)(xa + ks * 32), *(const bf16x8*)(wdt + ks * 32), acc);
                    if (r16 < 8) {
#pragma unroll
                        for (int j = 0; j < 4; ++j) { const unsigned row = rb * 16 + q4 * 4 + j; dtraw[row * 8u + r16] = acc[j] * row_rstd(ssq_in, row); }
                    }
                }
            }
            GRID_SYNC();

            const float* conv_w = args.in[7] + layer * 4 * 1024; const float* conv_b = args.in[8] + layer * 1024;
#endif
#ifndef MIXREP
#define MIXREP 1
#endif
#ifndef REPMASK
#define REPMASK 0
#endif
            for (int rep_ = 0; rep_ < MIXREP; ++rep_) {
#if PH & 8
            for (int rp_ = 0; rp_ < ((REPMASK & 8) ? 2 : 1); ++rp_)
            for (int u0_ = bid; u0_ < BATCH * NCH * 2; u0_ += G) {
                PHASE_IDS();
                const int unit = xsw ? ((u0_ & 7) * 64 + ((u0_ & 255) >> 3) + 32 * (u0_ >> 8)) : u0_;
                const int g2 = unit & 1, c = (unit >> 1) & 31, b = unit >> 6;
                const size_t grow0 = (size_t)b * SEQ + c * 128;
                LAS bf16* xT = (LAS bf16*)lds;
                LAS bf16* BTs = (LAS bf16*)(lds + 69632);
                LAS float* s_dt = (LAS float*)(lds + 104448); LAS float* s_acs = s_dt + 512;
                u32x4 Rraw[19]; f32x4 Rw[8]; f32x4 Rb[2]; float dx[4] = {0.f, 0.f, 0.f, 0.f};
#pragma unroll
                for (int i = 0; i < 19; ++i) Rraw[i] = (u32x4){0u, 0u, 0u, 0u};
#pragma unroll
                for (int i = 0; i < 8; ++i) Rw[i] = (f32x4){0.f, 0.f, 0.f, 0.f};
                Rb[0] = (f32x4){0.f, 0.f, 0.f, 0.f}; Rb[1] = (f32x4){0.f, 0.f, 0.f, 0.f};
                const int cgi = tid >> 3, l0 = (tid & 7) * 16;
                if (wave < 4) conv_load(Rraw, Rw, Rb, proj, conv_w, conv_b, PC_XBC + g2 * 256 + cgi * 8, grow0, c, l0);
                else if (wave < 6) conv_load(Rraw, Rw, Rb, proj, conv_w, conv_b, PC_XBC + 512 + g2 * 128 + (cgi - 32) * 8, grow0, c, l0);
                else {
#pragma unroll
                    for (int k = 0; k < 2; ++k) { const int h = g2 * 4 + (wave - 6) * 2 + k; const float dtb = args.in[9][layer * 8 + h];
                        dx[2 * k] = dtraw[(grow0 + 2 * lane) * 8 + h] + dtb; dx[2 * k + 1] = dtraw[(grow0 + 2 * lane + 1) * 8 + h] + dtb; }
#pragma unroll
                    for (int k = 0; k < 2; ++k) { const int hh = (wave - 6) * 2 + k; ssd_dt_acs_wave(dx[2 * k], dx[2 * k + 1], -__expf(args.in[10][layer * 8 + g2 * 4 + hh]), s_dt + hh * 128, s_acs + hh * 128, lane); }
                }
                __syncthreads();
                if (wave < 4) {
                    const int hh = cgi >> 3, pl = (cgi & 7) * 8; const float acs_end = s_acs[hh * 128 + 127];
                    LAS bf16* dst = xT + hh * (64 * 136);
                    conv_apply(Rraw, Rw, Rb, l0, [&](int l, const float (&o)[8]) {
                        const float sc = s_dt[hh * 128 + l] * __expf(acs_end - s_acs[hh * 128 + l]);
#pragma unroll
                        for (int i = 0; i < 8; ++i) dst[(pl + i) * 136 + l] = f2bf(o[i] * sc); });
                } else if (wave < 6) {
                    const int nl = (cgi - 32) * 8;
                    conv_apply(Rraw, Rw, Rb, l0, [&](int l, const float (&o)[8]) {
#pragma unroll
                        for (int i = 0; i < 8; ++i) BTs[(nl + i) * 136 + l] = f2bf(o[i]); });
                }
                __syncthreads();
                {
                    bf16x8 bfr[4];
#pragma unroll
                    for (int ks = 0; ks < 4; ++ks) bfr[ks] = lds_frag(BTs, 16 * wave + r16, 136, ks * 32 + q4 * 8);
#pragma unroll
                    for (int hh = 0; hh < 4; ++hh) {
                        f32x4 acc[4];
#pragma unroll
                        for (int pt = 0; pt < 4; ++pt) acc[pt] = (f32x4){0.f, 0.f, 0.f, 0.f};
#pragma unroll
                        for (int ks = 0; ks < 4; ++ks)
#pragma unroll
                            for (int pt = 0; pt < 4; ++pt) acc[pt] = mfma16(bfr[ks], lds_frag(xT + hh * (64 * 136), 16 * pt + r16, 136, ks * 32 + q4 * 8), acc[pt]);
                        const int unit8 = ((b * NCH + c) * 8) + g2 * 4 + hh;
                        float* st = ST + (size_t)unit8 * 8192;
#pragma unroll
                        for (int pt = 0; pt < 4; ++pt) *(f32x4*)(st + (16 * pt + r16) * 128 + 16 * wave + q4 * 4) = acc[pt];
                    }
                }
                if (tid < 4) CD[((b * NCH + c) * 2 + g2) * 32 + tid] = __expf(s_acs[tid * 128 + 127]);
                __syncthreads();
            }
#endif
#if PH & 16
            for (int rp_ = 0; rp_ < ((REPMASK & 16) ? 2 : 1); ++rp_)
            for (int u0_ = bid; u0_ < BATCH * NCH; u0_ += G) {
                PHASE_IDS();
                const int unit = xsw ? ((u0_ & 7) * 32 + (u0_ >> 3)) : u0_;
                const int nb = unit & 31, b = unit >> 5;
                const size_t grow0 = (size_t)b * SEQ + nb * 128;
                LAS bf16* Ks = (LAS bf16*)lds; LAS bf16* VT = (LAS bf16*)(lds + 36864); LAS bf16* Ps = (LAS bf16*)(lds + 72704) + wave * (16 * 168);
                LAS float* s_bias = (LAS float*)(lds + 115712);
                s_bias[tid] = args.in[14][T5_BUCKET[tid & 127] * 4 + (tid >> 7)];
                for (int it = tid; it < 64 * 24; it += 512) { const int d = it / 24, j = 256 + it % 24; VT[d * 280 + j] = 0; }
                f32x4 og[4][4]; float ssr[4] = {0.f, 0.f, 0.f, 0.f};
#pragma unroll
                for (int kvh = 0; kvh < 2; ++kvh) {
                    if (kvh) __syncthreads();
                    {
                        u32x4 kq[4], vq[4];
#pragma unroll
                        for (int k = 0; k < 4; ++k) {
                            const int it = tid + 512 * k, j = it >> 3, d8 = (it & 7) * 8;
                            kq[k] = (u32x4){0u, 0u, 0u, 0u}; vq[k] = (u32x4){0u, 0u, 0u, 0u};
                            if (nb > 0 || j >= 128) { const bf16* src = proj + (grow0 + j - 128) * NPROJ + kvh * 64 + d8; kq[k] = *(const u32x4*)(src + PC_K); vq[k] = *(const u32x4*)(src + PC_V); }
                        }
#pragma unroll
                        for (int k = 0; k < 4; ++k) {
                            const int it = tid + 512 * k, j = it >> 3, d8 = (it & 7) * 8;
                            *(LAS u32x4*)(Ks + j * 72 + d8) = kq[k];
                            const unsigned vw[4] = {vq[k].x, vq[k].y, vq[k].z, vq[k].w};
#pragma unroll
                            for (int i = 0; i < 4; ++i) { VT[(d8 + 2 * i) * 280 + j] = (bf16)(vw[i] & 0xffffu); VT[(d8 + 2 * i + 1) * 280 + j] = (bf16)(vw[i] >> 16); }
                        }
                    }
                    __syncthreads();
#pragma unroll
                    for (int g = 0; g < 2; ++g) {
                        const int hq = kvh * 2 + g;
                        const float sink = args.in[13][layer * 4 + hq];
                        const bf16* qp = proj + (grow0 + 16 * wave + r16) * NPROJ + PC_Q + hq * 64 + q4 * 8;
                        const bf16x8 aq0 = *(const bf16x8*)qp, aq1 = *(const bf16x8*)(qp + 32);
                        f32x4 sc[9];
#pragma unroll
                        for (int kk = 0; kk < 9; ++kk) {
                            const int krow = 16 * (wave + kk) + r16;
                            f32x4 a = (f32x4){0.f, 0.f, 0.f, 0.f};
                            a = mfma16(aq0, lds_frag(Ks, krow, 72, q4 * 8), a);
                            a = mfma16(aq1, lds_frag(Ks, krow, 72, 32 + q4 * 8), a);
                            sc[kk] = a;
                        }
                        float sm[4];
#pragma unroll
                        for (int j = 0; j < 4; ++j) {
                            const int i = 16 * wave + q4 * 4 + j; float m = -INFINITY;
#pragma unroll
                            for (int kk = 0; kk < 9; ++kk) {
                                const int jk = 16 * (wave + kk) + r16, dist = i - jk + 128;
                                const bool ok = (dist >= 0) && (dist < 128) && (nb > 0 || jk >= 128);
                                const float sv = ok ? sc[kk][j] * 0.125f + s_bias[hq * 128 + (dist & 127)] : -INFINITY;
                                sc[kk][j] = sv; m = fmaxf(m, sv);
                            }
                            m = fmaxf(max16(m), sink);
                            float su = 0.f;
#pragma unroll
                            for (int kk = 0; kk < 9; ++kk) { const float p = __expf(sc[kk][j] - m); sc[kk][j] = p; su += p; }
                            sm[j] = sum16(su) + __expf(sink - m);
                        }
#pragma unroll
                        for (int kk = 0; kk < 9; ++kk)
#pragma unroll
                            for (int j = 0; j < 4; ++j) Ps[(q4 * 4 + j) * 168 + kk * 16 + r16] = f2bf(sc[kk][j]);
                        *(LAS u32x2*)(Ps + (lane >> 2) * 168 + 144 + (lane & 3) * 4) = (u32x2){0u, 0u};
                        f32x4 oa[4];
#pragma unroll
                        for (int dt = 0; dt < 4; ++dt) oa[dt] = (f32x4){0.f, 0.f, 0.f, 0.f};
#pragma unroll
                        for (int ks = 0; ks < 5; ++ks) {
                            const bf16x8 pa = lds_frag(Ps, r16, 168, ks * 32 + q4 * 8);
#pragma unroll
                            for (int dt = 0; dt < 4; ++dt) oa[dt] = mfma16(pa, lds_frag(VT, 16 * dt + r16, 280, 16 * wave + ks * 32 + q4 * 8), oa[dt]);
                        }
#pragma unroll
                        for (int j = 0; j < 4; ++j) { const float inv = 1.f / sm[j];
#pragma unroll
                            for (int dt = 0; dt < 4; ++dt) { const float o = oa[dt][j] * inv; ssr[j] += o * o; og[hq][dt][j] = o; } }
                    }
                }
#pragma unroll
                for (int hq = 0; hq < 4; ++hq) {
#pragma unroll
                    for (int j = 0; j < 4; ++j) {
                        const size_t row = grow0 + 16 * wave + q4 * 4 + j; float ss = 0.f;
#pragma unroll
                        for (int dt = 0; dt < 4; ++dt) { const float o = og[hq][dt][j]; ss += o * o; Yg[row * DM + 512 + hq * 64 + 16 * dt + r16] = f2bf(o); }
                        ss = sum16(ss);
                        if (r16 == 0) mss_a[(size_t)hq * MTOK + row] = ss;
                    }
                }
                __syncthreads();
            }
#endif
#if PH & 32
            for (int rp_ = 0; rp_ < ((REPMASK & 32) ? 2 : 1); ++rp_)
            for (int u0_ = bid; u0_ < BATCH * NCH; u0_ += G) {
                PHASE_IDS();
                const int unit = xsw ? ((u0_ & 7) * 32 + (u0_ >> 3)) : u0_;
                const int c = unit & 31, b = unit >> 5;
                const size_t grow0 = (size_t)b * SEQ + c * 128;
                LAS bf16* vnT = (LAS bf16*)lds;
                LAS bf16* Us = (LAS bf16*)(lds + 69632);
                const int l = tid >> 2, sub = tid & 3;
                u32x4 gvr[8], ur[8]; bf16x8 wa[4][4];
                {
                    const bf16* src = proj + (grow0 + l) * NPROJ + PC_GV + sub * 64;
#pragma unroll
                    for (int k = 0; k < 8; ++k) gvr[k] = *(const u32x4*)(src + 8 * k);
#pragma unroll
                    for (int k = 0; k < 8; ++k) { const int it = tid + 512 * k, t = it >> 5, c8 = (it & 31) * 8; ur[k] = *(const u32x4*)(proj + (grow0 + t) * NPROJ + PC_U + c8); }
                }
                {
                    float v[64]; float sm = 0.f;
#pragma unroll
                    for (int k = 0; k < 8; ++k) { float t8[8]; unpack8(gvr[k], t8);
#pragma unroll
                        for (int i = 0; i < 8; ++i) { v[8 * k + i] = gelu_f(t8[i]); sm += v[8 * k + i]; } }
                    sm += __shfl_xor(sm, 1); sm += __shfl_xor(sm, 2);
                    const float mean = sm * (1.f / 256.f); float qv = 0.f;
#pragma unroll
                    for (int i = 0; i < 64; ++i) { const float d = v[i] - mean; qv += d * d; }
                    qv += __shfl_xor(qv, 1); qv += __shfl_xor(qv, 2);
                    const float rstd = rsqrtf(qv * (1.f / 256.f) + EPS);
                    const float* lw = args.in[16] + layer * 256 + sub * 64; const float* lb = args.in[17] + layer * 256 + sub * 64;
                    LAS bf16* dst = vnT + sub * (64 * 136) + l;
#pragma unroll
                    for (int i = 0; i < 64; ++i) dst[i * 136] = f2bf((v[i] - mean) * rstd * lw[i] + lb[i]);
                }
#pragma unroll
                for (int k = 0; k < 8; ++k) { const int it = tid + 512 * k, t = it >> 5, c8 = (it & 31) * 8; *(LAS u32x4*)(Us + t * 264 + c8) = ur[k]; }
#pragma unroll
                for (int gi = 0; gi < 4; ++gi)
#pragma unroll
                    for (int ks = 0; ks < 4; ++ks) wa[gi][ks] = *(const bf16x8*)(sguW + (size_t)(layer * 4 + gi) * 16384 + (16 * wave + r16) * 128 + ks * 32 + q4 * 8);
                __syncthreads();
                {
                    f32x4 og[4][4]; float ss[4] = {0.f, 0.f, 0.f, 0.f};
#pragma unroll
                    for (int gi = 0; gi < 4; ++gi) {
                        f32x4 acc[4];
#pragma unroll
                        for (int dt = 0; dt < 4; ++dt) acc[dt] = (f32x4){0.f, 0.f, 0.f, 0.f};
#pragma unroll
                        for (int ks = 0; ks < 4; ++ks) {
                            if (2 * ks <= wave) {
#pragma unroll
                                for (int dt = 0; dt < 4; ++dt) acc[dt] = mfma16(wa[gi][ks], lds_frag(vnT + gi * (64 * 136), 16 * dt + r16, 136, ks * 32 + q4 * 8), acc[dt]);
                            }
                        }
#pragma unroll
                        for (int j = 0; j < 4; ++j) {
                            const int t = 16 * wave + q4 * 4 + j; const float bs = args.in[19][(layer * 4 + gi) * 128 + t];
#pragma unroll
                            for (int dt = 0; dt < 4; ++dt) {
                                const float uu = gelu_f(bf2f(Us[t * 264 + gi * 64 + 16 * dt + r16]));
                                const float o = uu * (acc[dt][j] + bs); ss[j] += o * o; og[gi][dt][j] = o;
                            }
                        }
                    }
                    float rs[4];
#pragma unroll
                    for (int j = 0; j < 4; ++j) rs[j] = rsqrtf(sum16(ss[j]) * (1.f / 256.f) + EPS);
#pragma unroll
                    for (int gi = 0; gi < 4; ++gi)
#pragma unroll
                        for (int dt = 0; dt < 4; ++dt) {
                            const int col = gi * 64 + 16 * dt + r16; const float nw = args.in[20][layer * 256 + col];
#pragma unroll
                            for (int j = 0; j < 4; ++j) ycat[(grow0 + 16 * wave + q4 * 4 + j) * DM + 768 + col] = f2bf(og[gi][dt][j] * rs[j] * nw);
                        }
                }
                __syncthreads();
            }
            GRID_SYNC();
#endif
#if PH & 64
            for (int rp_ = 0; rp_ < ((REPMASK & 64) ? 2 : 1); ++rp_)
            { PHASE_IDS();
            for (int e = (xsw ? ((bid & 7) * 32 + (bid >> 3)) : bid) * 512 + tid; e < BATCH * 8 * 2048; e += G * 512) {
                const int i4 = e & 2047, h = (e >> 11) & 7, b = e >> 14;
                f32x4 carry = (f32x4){0.f, 0.f, 0.f, 0.f};
#pragma unroll 8
                for (int c = 0; c < NCH; ++c) {
                    const int unit = (b * NCH + c) * 8 + h;
                    const f32x4 st = *(const f32x4*)(ST + (size_t)unit * 8192 + i4 * 4); const float dec = CD[((b * NCH + c) * 2 + (h >> 2)) * 32 + (h & 3)];
                    u32x2 w; w.x = pk2(carry.x, carry.y); w.y = pk2(carry.z, carry.w); *(u32x2*)(PV + (size_t)unit * 8192 + i4 * 4) = w;
                    carry = carry * dec + st;
                }
            } }
            GRID_SYNC();
#endif
#if PH & 128
            for (int rp_ = 0; rp_ < ((REPMASK & 128) ? 2 : 1); ++rp_)
            for (int u0_ = bid; u0_ < BATCH * NCH * 2; u0_ += G) {
                PHASE_IDS();
                const int unit = xsw ? ((u0_ & 7) * 64 + ((u0_ & 255) >> 3) + 32 * (u0_ >> 8)) : u0_;
                const int g2 = unit & 1, c = (unit >> 1) & 31, b = unit >> 6;
                const size_t grow0 = (size_t)b * SEQ + c * 128;
                LAS bf16* Cs = (LAS bf16*)lds; LAS bf16* Bs = (LAS bf16*)(lds + 34816); LAS bf16* Ms = Bs;
                LAS bf16* xT = (LAS bf16*)(lds + 69632);
                LAS float* s_dt = (LAS float*)(lds + 139264); LAS float* s_acs = s_dt + 512;
                u32x4 Rraw[19]; f32x4 Rw[8]; f32x4 Rb[2]; float dx0 = 0.f, dx1 = 0.f;
                const int cgi = tid >> 3, l0 = (tid & 7) * 16;
                if (wave < 4) {
                    conv_load(Rraw, Rw, Rb, proj, conv_w, conv_b, PC_XBC + g2 * 256 + cgi * 8, grow0, c, l0);
                    const int h = g2 * 4 + wave; const float dtb = args.in[9][layer * 8 + h];
                    dx0 = dtraw[(grow0 + 2 * lane) * 8 + h] + dtb; dx1 = dtraw[(grow0 + 2 * lane + 1) * 8 + h] + dtb;
                } else if (wave < 6) conv_load(Rraw, Rw, Rb, proj, conv_w, conv_b, PC_XBC + 512 + g2 * 128 + (cgi - 32) * 8, grow0, c, l0);
                else conv_load(Rraw, Rw, Rb, proj, conv_w, conv_b, PC_XBC + 768 + g2 * 128 + (cgi - 48) * 8, grow0, c, l0);
                if (wave < 4) {
                    const int hh = cgi >> 3, pl = (cgi & 7) * 8;
                    LAS bf16* dst = xT + hh * (64 * 136);
                    conv_apply(Rraw, Rw, Rb, l0, [&](int l, const float (&o)[8]) {
#pragma unroll
                        for (int i = 0; i < 8; ++i) dst[(pl + i) * 136 + l] = f2bf(o[i]); });
                    ssd_dt_acs_wave(dx0, dx1, -__expf(args.in[10][layer * 8 + g2 * 4 + wave]), s_dt + wave * 128, s_acs + wave * 128, lane);
                } else if (wave < 6) {
                    const int nl = (cgi - 32) * 8;
                    conv_apply(Rraw, Rw, Rb, l0, [&](int l, const float (&o)[8]) { *(LAS u32x4*)(Bs + l * 136 + nl) = pack8(o); });
                } else {
                    const int nl = (cgi - 48) * 8;
                    conv_apply(Rraw, Rw, Rb, l0, [&](int l, const float (&o)[8]) { *(LAS u32x4*)(Cs + l * 136 + nl) = pack8(o); });
                }
                __syncthreads();
                {
                    const int lrow = 16 * wave + r16;
                    bf16x8 ca[4];
#pragma unroll
                    for (int ks = 0; ks < 4; ++ks) ca[ks] = lds_frag(Cs, lrow, 136, ks * 32 + q4 * 8);
                    f32x4 cbr[8];
#pragma unroll
                    for (int st = 0; st < 8; ++st) {
                        cbr[st] = (f32x4){0.f, 0.f, 0.f, 0.f};
                        if (st <= wave) {
#pragma unroll
                            for (int ks = 0; ks < 4; ++ks) cbr[st] = mfma16(ca[ks], lds_frag(Bs, 16 * st + r16, 136, ks * 32 + q4 * 8), cbr[st]);
                        }
                    }
                    __syncthreads();
#pragma unroll 1
                    for (int hh = 0; hh < 4; ++hh) {
                        const int h = g2 * 4 + hh; const int unit8 = ((b * NCH + c) * 8) + h;
                        bf16x8 pvf[4][4];
                        {
                            const bf16* pv = PV + (size_t)unit8 * 8192;
#pragma unroll
                            for (int ks = 0; ks < 4; ++ks)
#pragma unroll
                                for (int pt = 0; pt < 4; ++pt) pvf[ks][pt] = *(const bf16x8*)(pv + (16 * pt + r16) * 128 + ks * 32 + q4 * 8);
                        }
                        bf16 zr[4][4];
#pragma unroll
                        for (int j = 0; j < 4; ++j)
#pragma unroll
                            for (int pt = 0; pt < 4; ++pt) zr[j][pt] = proj[(grow0 + 16 * wave + q4 * 4 + j) * NPROJ + PC_Z + h * 64 + 16 * pt + r16];
                        const LAS float* hdt = s_dt + hh * 128; const LAS float* hacs = s_acs + hh * 128;
                        float acl[4];
#pragma unroll
                        for (int j = 0; j < 4; ++j) acl[j] = hacs[16 * wave + q4 * 4 + j];
#pragma unroll
                        for (int st = 0; st < 8; ++st) {
                            if (st <= (wave | 1)) {
                                const int sI = 16 * st + r16; const float acss = hacs[sI], dts = hdt[sI];
#pragma unroll
                                for (int j = 0; j < 4; ++j) { const int l = 16 * wave + q4 * 4 + j; const float mv = (sI <= l) ? cbr[st][j] * __expf(fminf(acl[j] - acss, 0.f)) * dts : 0.f; Ms[l * 136 + sI] = f2bf(mv); }
                            }
                        }
                        f32x4 yo[4], yd[4];
#pragma unroll
                        for (int pt = 0; pt < 4; ++pt) { yo[pt] = (f32x4){0.f, 0.f, 0.f, 0.f}; yd[pt] = (f32x4){0.f, 0.f, 0.f, 0.f}; }
                        const LAS bf16* xh = xT + hh * (64 * 136);
#pragma unroll
                        for (int ks = 0; ks < 4; ++ks) {
                            if (2 * ks <= wave) {
                                const bf16x8 ma = lds_frag(Ms, lrow, 136, ks * 32 + q4 * 8);
#pragma unroll
                                for (int pt = 0; pt < 4; ++pt) yd[pt] = mfma16(ma, lds_frag(xh, 16 * pt + r16, 136, ks * 32 + q4 * 8), yd[pt]);
                            }
                        }
#pragma unroll
                        for (int ks = 0; ks < 4; ++ks)
#pragma unroll
                            for (int pt = 0; pt < 4; ++pt) yo[pt] = mfma16(ca[ks], pvf[ks][pt], yo[pt]);
                        const float Dh = args.in[11][layer * 8 + h];
#pragma unroll
                        for (int j = 0; j < 4; ++j) {
                            const int l = 16 * wave + q4 * 4 + j; const size_t row = grow0 + l; const float ea = __expf(acl[j]); float ss = 0.f;
#pragma unroll
                            for (int pt = 0; pt < 4; ++pt) {
                                const int p = 16 * pt + r16;
                                const float y = yd[pt][j] + ea * yo[pt][j] + Dh * bf2f(xh[p * 136 + l]);
                                const float o = y * silu_f(bf2f(zr[j][pt])); ss += o * o; Yg[row * DM + h * 64 + p] = f2bf(o);
                            }
                            ss = sum16(ss);
                            if (r16 == 0) mss_g[((size_t)g2 * MTOK + row) * 4 + hh] = ss;
                        }
                    }
                }
                __syncthreads();
            }
            GRID_SYNC();
#endif
#if PH & 256
            for (int rp_ = 0; rp_ < ((REPMASK & 256) ? 2 : 1); ++rp_)
            for (int m0 = gw; m0 < MTOK; m0 += 4 * NGW) {
                PHASE_IDS();
                f32x4 sv[4][3]; u32x4 yv[4][2];
                const int colA = lane * 8, colB = 512 + lane * 8;
#pragma unroll
                for (int r = 0; r < 4; ++r) { const int m = min(m0 + r * NGW, MTOK - 1);
                    sv[r][0] = *(const f32x4*)(mss_g + (size_t)m * 4); sv[r][1] = *(const f32x4*)(mss_g + ((size_t)MTOK + m) * 4); sv[r][2] = (f32x4){mss_a[m], mss_a[(size_t)MTOK + m], mss_a[(size_t)2 * MTOK + m], mss_a[(size_t)3 * MTOK + m]};
                    yv[r][0] = *(const u32x4*)(Yg + (size_t)m * DM + colA); yv[r][1] = *(const u32x4*)(Yg + (size_t)m * DM + 512 + (lane & 31) * 8); }
                float nwA[8], nwB[8];
                { const float* p = args.in[12] + layer * 512 + colA;
#pragma unroll
                  for (int i = 0; i < 8; ++i) nwA[i] = p[i];
                  const float* q = args.in[15] + layer * 256 + (lane & 31) * 8;
#pragma unroll
                  for (int i = 0; i < 8; ++i) nwB[i] = q[i]; }
#pragma unroll
                for (int r = 0; r < 4; ++r) { const int m = m0 + r * NGW; if (m < MTOK) {
                    const f32x4 s0 = sv[r][0], s1 = sv[r][1], s2 = sv[r][2];
                    const float r_ssd = rsqrtf((((s0.x + s0.y) + (s0.z + s0.w)) + ((s1.x + s1.y) + (s1.z + s1.w))) * (1.f / 512.f) + EPS);
                    const float r_att = rsqrtf(((s2.x + s2.y) + (s2.z + s2.w)) * (1.f / 256.f) + EPS);
                    float v[8]; unpack8(yv[r][0], v);
#pragma unroll
                    for (int i = 0; i < 8; ++i) v[i] = v[i] * r_ssd * nwA[i];
                    *(u32x4*)(ycat + (size_t)m * DM + colA) = pack8(v);
                    if (lane < 32) { unpack8(yv[r][1], v);
#pragma unroll
                        for (int i = 0; i < 8; ++i) v[i] = v[i] * r_att * nwB[i];
                        *(u32x4*)(ycat + (size_t)m * DM + colB) = pack8(v); } } }
            }
            GRID_SYNC();
#endif
            }
#if PH & 512
            {
                pg8::Gemm g{ycat, Wl + WL_OUT / 2, MTOK, DM, DM}; pg8::StaticOrder S; S.init(MTOK, DM, G, bid);
                EpiResid E{xb, ssq + (size_t)(3 * layer + 2) * MTOK * 4, 1.0f, (LAS float*)(lds + 131072)};
                pg8::gemm_phase<EpiResid, pg8::StaticOrder, true, true>(lds, g, S, E);
            }
            GRID_SYNC();
#endif
        }
    }
#if PH & 1024
    for (int m0 = gw; m0 < MTOK; m0 += 4 * NGW) {
        PHASE_IDS();
        u32x4 xv[4][2]; f32x4 pv4[4];
#pragma unroll
        for (int r = 0; r < 4; ++r) { const int m = min(m0 + r * NGW, MTOK - 1);
            const u32x4* xr = (const u32x4*)(xb + (size_t)m * DM) + lane; xv[r][0] = xr[0]; xv[r][1] = xr[64];
            pv4[r] = *(const f32x4*)(ssq + (size_t)6 * MTOK * 4 + (size_t)m * 4); }
        const f32x4* wv = (const f32x4*)args.in[26];
        f32x4 wq[2][2];
#pragma unroll
        for (int j = 0; j < 2; ++j) { const int c4 = (64 * j + lane) * 2; wq[j][0] = wv[c4]; wq[j][1] = wv[c4 + 1]; }
#pragma unroll
        for (int r = 0; r < 4; ++r) { const int m = m0 + r * NGW; if (m < MTOK) {
            const float rs = rstd4(pv4[r]); f32x4* orow = (f32x4*)(args.out + (size_t)m * DM);
#pragma unroll
            for (int j = 0; j < 2; ++j) {
                float v[8]; unpack8(xv[r][j], v);
                const int c4 = (64 * j + lane) * 2; const f32x4 w0 = wq[j][0], w1 = wq[j][1];
                orow[c4] = (f32x4){v[0] * rs * w0.x, v[1] * rs * w0.y, v[2] * rs * w0.z, v[3] * rs * w0.w};
                orow[c4 + 1] = (f32x4){v[4] * rs * w1.x, v[5] * rs * w1.y, v[6] * rs * w1.z, v[7] * rs * w1.w};
            } } }
    }
#endif
}

extern "C" void kernel_launch(void* const* d_in, const int* in_sizes, int n_in, void* d_out, int out_size, void* d_ws, size_t ws_size, hipStream_t stream) {
    static int grid = 0;
    if (grid == 0) {
        if (n_in != 27 || out_size != MTOK * DM || ws_size < WS_END) { fprintf(stderr, "kernel_launch: unexpected shapes (n_in %d, out %d, ws %zu)\n", n_in, out_size, ws_size); grid = -1; return; }
        int dev = 0, cus = 0, per_cu = 0;
        hipGetDevice(&dev); hipDeviceGetAttribute(&cus, hipDeviceAttributeMultiprocessorCount, dev);
        if (hipFuncSetAttribute((const void*)fwd_megakernel, hipFuncAttributeMaxDynamicSharedMemorySize, LDS_BYTES) != hipSuccess) { fprintf(stderr, "kernel_launch: hipFuncSetAttribute failed\n"); grid = -1; return; }
        if (hipOccupancyMaxActiveBlocksPerMultiprocessor(&per_cu, (const void*)fwd_megakernel, 512, LDS_BYTES) != hipSuccess || per_cu < 1) { fprintf(stderr, "kernel_launch: occupancy query gave %d\n", per_cu); per_cu = 1; }
        (void)hipGetLastError();
        grid = cus * 1;
        fprintf(stderr, "kernel_launch: cus %d per_cu %d grid %d\n", cus, per_cu, grid);
    }
    if (grid < 0) return;
    if (hipMemsetAsync((char*)d_ws + WS_BAR, 0, XCD_BAR_WORDS * 4, stream) != hipSuccess) { fprintf(stderr, "kernel_launch: memset failed\n"); return; }
    Args a{};
    for (int i = 0; i < 27; ++i) a.in[i] = (const float*)d_in[i];
    a.out = (float*)d_out; a.ws = (unsigned char*)d_ws;
    void* kargs[] = {&a};
    hipError_t e = hipLaunchCooperativeKernel((const void*)fwd_megakernel, dim3(grid), dim3(512), kargs, LDS_BYTES, stream);
    if (e != hipSuccess) fprintf(stderr, "kernel_launch: cooperative launch failed: %s (grid %d)\n", hipGetErrorString(e), grid);
}
```

```cpp
#include <hip/hip_runtime.h>
#include <hip/hip_cooperative_groups.h>
#include <cstdio>
#include <cstdint>
namespace cg = cooperative_groups;
namespace pg8 {
#define PG8_LAS __attribute__((address_space(3)))
typedef unsigned short bf16_t;
typedef short bf16x8 __attribute__((ext_vector_type(8)));
typedef float f32x4 __attribute__((ext_vector_type(4)));
typedef unsigned u32x4 __attribute__((ext_vector_type(4)));
constexpr int BM = 256, BK = 64, HALF = 128, HTB = HALF * BK * 2  , STAGE_BYTES = 8 * HTB, NXCD = 8, WGM = 8;

__host__ __device__ __forceinline__ int lds_byte(int r, int c) { const int st = (r >> 4) * 2 + (c >> 5), rr = r & 15, cc = c & 31, ob = rr * 64 + cc * 2; return st * 1024 + (ob ^ (((ob >> 9) & 1) << 5)); }
__host__ __device__ __forceinline__ void stage_rc(int b, int& R, int& C) { const int st = b / 1024, sb = b % 1024, swz = sb ^ (((sb >> 9) & 1) << 5); R = (st >> 1) * 16 + swz / 64; C = (st & 1) * 32 + (swz % 64) / 2; }
__host__ __device__ __forceinline__ int perm32(int rho) { const int n = rho >> 4, i = rho & 15; return 8 * (i >> 2) + 4 * n + (i & 3); }

struct Unit { int pm, pn; };
struct Gemm { const bf16_t* A; const bf16_t* Bt; int M, N, K; };

struct StaticOrder {
    int nM, nN, nwg, G, c;
    __host__ __device__ void init(int M, int N, int G_, int c_) { nM = M / BM; nN = N / BM; nwg = nM * nN; G = G_; c = c_; }
    __host__ __device__ bool next(int i, Unit& u) const {
        const long L = (long)i * G + c; if (L >= nwg) return false;
        int wgid = (int)L; { const int q = nwg / NXCD, r = nwg % NXCD, xcd = wgid % NXCD, off = wgid / NXCD; wgid = (xcd < r ? xcd * (q + 1) : r * (q + 1) + (xcd - r) * q) + off; }
        const int nig = WGM * nN, gid = wgid / nig, fm = gid * WGM, gsz = (nM - fm) < WGM ? (nM - fm) : WGM;
        u.pm = fm + ((wgid % nig) % gsz); u.pn = (wgid % nig) / gsz; return true;
    }
    __device__ __forceinline__ void a_ready(const Unit&) const {}
    __device__ __forceinline__ void done(const Unit&) const {}
};

__device__ __forceinline__ unsigned cvt_pk_bf16(float lo, float hi) { unsigned r; asm volatile("v_cvt_pk_bf16_f32 %0, %1, %2" : "=v"(r) : "v"(lo), "v"(hi)); return r; }
typedef float f32x2 __attribute__((ext_vector_type(2)));
template <class Epi, class Sched, bool ALIGN_EPI = false, bool SP2 = false>
__device__ __forceinline__ void gemm_phase(PG8_LAS unsigned char* lds, const Gemm g, const Sched& S, const Epi& E) {
    int tid_; asm volatile("v_mov_b32 %0, %1" : "=v"(tid_) : "v"((int)threadIdx.x));
    const int tid = tid_, wid = __builtin_amdgcn_readfirstlane(tid >> 6), lane = tid & 63, wr = wid >> 2, wc = wid & 3, fr = lane & 15, fq = lane >> 4;
    const int K = g.K, nt = K / BK;
    unsigned voffA[2], voffB[2];
#pragma unroll
    for (int i = 0; i < 2; ++i) { int R, C; stage_rc(tid * 16 + i * 8192, R, C); const int Rb = Epi::PERM ? ((R & ~31) + perm32(R & 31)) : R;
        voffA[i] = (unsigned)(R * K + C) * 2u; voffB[i] = (unsigned)(Rb * K + C) * 2u; }
    const size_t kstep = (size_t)(BK * 2);
    const size_t hstep = (size_t)HALF * K * 2;
    const size_t tstep = 2 * hstep;
    const unsigned ldsw = (unsigned)wid * 1024u;
    const int aoff = lds_byte(wr * 64 + fr, fq * 8), boff = lds_byte(wc * 32 + fr, fq * 8);
#define PG8_SA(b, h) (((b) * 2 + (h)) * HTB)
#define PG8_SB(b, h) ((4 + (b) * 2 + (h)) * HTB)
#define PG8_STAGE(bufoff, gbase, voff) do { _Pragma("unroll") for (int _i = 0; _i < 2; ++_i) \
        __builtin_amdgcn_global_load_lds((const unsigned*)((const char*)(gbase) + (voff)[_i]), (PG8_LAS unsigned*)(lds + (bufoff) + ldsw + _i * 8192), 16, 0, 0); } while (0)
#define PG8_LDA(dst, b, h) do { _Pragma("unroll") for (int m = 0; m < 4; ++m) _Pragma("unroll") for (int k = 0; k < 2; ++k) dst[m][k] = *(const PG8_LAS bf16x8*)(lds + PG8_SA(b, h) + aoff + m * 2048 + k * 1024); } while (0)
#define PG8_LDB(dst, b, h) do { _Pragma("unroll") for (int n = 0; n < 2; ++n) _Pragma("unroll") for (int k = 0; k < 2; ++k) dst[n][k] = *(const PG8_LAS bf16x8*)(lds + PG8_SB(b, h) + boff + n * 2048 + k * 1024); } while (0)
#define PG8_MMA(ai, bj, At, Bt) do { __builtin_amdgcn_s_setprio(1); _Pragma("unroll") for (int m = 0; m < 4; ++m) _Pragma("unroll") for (int n = 0; n < 2; ++n) _Pragma("unroll") for (int k = 0; k < 2; ++k) \
        acc[ai][bj][m][n] = __builtin_amdgcn_mfma_f32_16x16x32_bf16(Bt[n][k], At[m][k], acc[ai][bj][m][n], 0, 0, 0); __builtin_amdgcn_s_setprio(0); } while (0)
#define PG8_WAIT_V(n) asm volatile("s_waitcnt vmcnt(" #n ")" ::: "memory")
#define PG8_WAIT_L(n) asm volatile("s_waitcnt lgkmcnt(" #n ")" ::: "memory")
#define PG8_BAR __builtin_amdgcn_s_barrier()
#define PG8_SCHED __builtin_amdgcn_sched_barrier(0)
    Unit cur, nxt; int ui = 0;
    if (!S.next(0, cur)) return;
    f32x4 acc[2][2][4][2];
#pragma unroll
    for (int a = 0; a < 2; ++a)
#pragma unroll
        for (int b = 0; b < 2; ++b)
#pragma unroll
            for (int m = 0; m < 4; ++m)
#pragma unroll
                for (int n = 0; n < 2; ++n) acc[a][b][m][n] = (f32x4){0.f, 0.f, 0.f, 0.f};
    bf16x8 At[4][2], B0[2][2], B1[2][2];
    const char* cA = (const char*)g.A + (size_t)cur.pm * tstep; const char* cB = (const char*)g.Bt + (size_t)cur.pn * tstep;
    S.a_ready(cur);
    if constexpr (SP2) {
        PG8_STAGE(PG8_SB(0, 0), cB, voffB); PG8_STAGE(PG8_SB(0, 1), cB + hstep, voffB); PG8_STAGE(PG8_SA(0, 0), cA, voffA); PG8_STAGE(PG8_SA(0, 1), cA + hstep, voffA);
        if (wr == 1) PG8_BAR;
        PG8_WAIT_V(2); PG8_BAR;
        PG8_STAGE(PG8_SB(1, 0), cB + kstep, voffB); PG8_STAGE(PG8_SA(1, 0), cA + kstep, voffA); PG8_STAGE(PG8_SB(1, 1), cB + hstep + kstep, voffB);
        PG8_WAIT_V(6); PG8_BAR;
    } else {
        PG8_STAGE(PG8_SB(0, 0), cB, voffB); PG8_STAGE(PG8_SA(0, 0), cA, voffA); PG8_STAGE(PG8_SB(0, 1), cB + hstep, voffB); PG8_STAGE(PG8_SA(0, 1), cA + hstep, voffA);
        if (wr == 1) PG8_BAR;
        PG8_WAIT_V(4); PG8_BAR;
        PG8_STAGE(PG8_SB(1, 0), cB + kstep, voffB); PG8_STAGE(PG8_SA(1, 0), cA + kstep, voffA); PG8_STAGE(PG8_SB(1, 1), cB + hstep + kstep, voffB);
        PG8_WAIT_V(6); PG8_BAR;
    }
    for (;;) {
        const bool has_next = S.next(ui + 1, nxt);
        const char* nA = has_next ? (const char*)g.A + (size_t)nxt.pm * tstep : cA; const char* nB = has_next ? (const char*)g.Bt + (size_t)nxt.pn * tstep : cB;
        for (int t = 0; t < nt; t += 2) {
            const bool last = (t == nt - 2);
            const char* a1 = cA + (size_t)(t + 1) * kstep;
            const char* a2 = last ? nA : cA + (size_t)(t + 2) * kstep; const char* b2 = last ? nB : cB + (size_t)(t + 2) * kstep;
            const char* a3 = a2 + kstep; const char* b3 = b2 + kstep;
            if (last && has_next) S.a_ready(nxt);
            if constexpr (SP2) {
            PG8_LDB(B0, 0, 0); PG8_LDB(B1, 0, 1); PG8_SCHED; PG8_LDA(At, 0, 0); PG8_STAGE(PG8_SA(1, 1), a1 + hstep, voffA);
            PG8_WAIT_V(8); PG8_WAIT_L(0); PG8_BAR; PG8_MMA(0, 0, At, B0); PG8_MMA(0, 1, At, B1); PG8_BAR; PG8_SCHED;
            PG8_LDA(At, 0, 1); PG8_STAGE(PG8_SB(0, 0), b2, voffB); PG8_STAGE(PG8_SB(0, 1), b2 + hstep, voffB); PG8_STAGE(PG8_SA(0, 0), a2, voffA);
            PG8_WAIT_V(8); PG8_WAIT_L(0); PG8_BAR; PG8_MMA(1, 0, At, B0); PG8_MMA(1, 1, At, B1); PG8_BAR; PG8_SCHED;
            PG8_LDB(B0, 1, 0); PG8_LDB(B1, 1, 1); PG8_SCHED; PG8_LDA(At, 1, 0); PG8_STAGE(PG8_SA(0, 1), a2 + hstep, voffA);
            PG8_WAIT_V(8); PG8_WAIT_L(0); PG8_BAR; PG8_MMA(0, 0, At, B0); PG8_MMA(0, 1, At, B1); PG8_BAR; PG8_SCHED;
            PG8_LDA(At, 1, 1); PG8_STAGE(PG8_SB(1, 0), b3, voffB); PG8_STAGE(PG8_SB(1, 1), b3 + hstep, voffB); PG8_STAGE(PG8_SA(1, 0), a3, voffA);
            PG8_WAIT_V(8); PG8_WAIT_L(0); PG8_BAR; PG8_MMA(1, 0, At, B0); PG8_MMA(1, 1, At, B1); PG8_BAR; PG8_SCHED;
            } else {
            PG8_LDB(B0, 0, 0); PG8_SCHED; PG8_LDA(At, 0, 0); PG8_STAGE(PG8_SA(1, 1), a1 + hstep, voffA);
            PG8_WAIT_L(8); PG8_BAR; PG8_WAIT_L(0); PG8_MMA(0, 0, At, B0); PG8_BAR; PG8_SCHED;
            PG8_LDB(B1, 0, 1); PG8_STAGE(PG8_SB(0, 0), b2, voffB);
            PG8_BAR; PG8_WAIT_L(0); PG8_MMA(0, 1, At, B1); PG8_BAR;
            PG8_LDA(At, 0, 1); PG8_STAGE(PG8_SA(0, 0), a2, voffA);
            PG8_BAR; PG8_WAIT_L(0); PG8_MMA(1, 0, At, B0); PG8_BAR; PG8_SCHED;
            PG8_STAGE(PG8_SB(0, 1), b2 + hstep, voffB);
            PG8_WAIT_V(6); PG8_BAR; PG8_MMA(1, 1, At, B1); PG8_BAR;
            PG8_LDB(B0, 1, 0); PG8_SCHED; PG8_LDA(At, 1, 0); PG8_STAGE(PG8_SA(0, 1), a2 + hstep, voffA);
            PG8_WAIT_L(8); PG8_BAR; PG8_WAIT_L(0); PG8_MMA(0, 0, At, B0); PG8_BAR; PG8_SCHED;
            PG8_LDB(B1, 1, 1); PG8_STAGE(PG8_SB(1, 0), b3, voffB);
            PG8_BAR; PG8_WAIT_L(0); PG8_MMA(0, 1, At, B1); PG8_BAR;
            PG8_LDA(At, 1, 1); PG8_STAGE(PG8_SA(1, 0), a3, voffA);
            PG8_BAR; PG8_WAIT_L(0); PG8_MMA(1, 0, At, B0); PG8_BAR; PG8_SCHED;
            PG8_STAGE(PG8_SB(1, 1), b3 + hstep, voffB);
            PG8_WAIT_V(6); PG8_BAR; PG8_MMA(1, 1, At, B1); PG8_BAR;
            }
        }
        if constexpr (ALIGN_EPI) { if (wr == 0) PG8_BAR; }
        if constexpr (!Epi::AFTER_DRAIN) { E(acc, cur, wr, wc, fr, fq); S.done(cur); }
        if (!has_next) break;
#pragma unroll
        for (int a = 0; a < 2; ++a)
#pragma unroll
            for (int b = 0; b < 2; ++b)
#pragma unroll
                for (int m = 0; m < 4; ++m)
#pragma unroll
                    for (int n = 0; n < 2; ++n) acc[a][b][m][n] = (f32x4){0.f, 0.f, 0.f, 0.f};
        cur = nxt; cA = nA; cB = nB; ++ui;
        if constexpr (ALIGN_EPI) { if (wr == 1) PG8_BAR; }
    }
    PG8_WAIT_V(0);
    if constexpr (!ALIGN_EPI) { if (wr == 0) PG8_BAR; }
    PG8_BAR;
    if constexpr (Epi::AFTER_DRAIN) { E.fused(acc, cur, wr, wc, fr, fq, lds, wid, lane); S.done(cur); }
#undef PG8_SA
#undef PG8_SB
#undef PG8_STAGE
#undef PG8_LDA
#undef PG8_LDB
#undef PG8_MMA
#undef PG8_WAIT_V
#undef PG8_WAIT_L
#undef PG8_BAR
#undef PG8_SCHED
}
}

#define LAS __attribute__((address_space(3)))
#define DI __device__ __forceinline__
typedef unsigned short bf16;
typedef short bf16x8 __attribute__((ext_vector_type(8)));
typedef float f32x4 __attribute__((ext_vector_type(4)));
typedef unsigned u32x4 __attribute__((ext_vector_type(4)));
typedef unsigned u32x2 __attribute__((ext_vector_type(2)));

constexpr int BATCH = 8, SEQ = 4096, DM = 1024, MTOK = BATCH * SEQ, DFF = 2816, DEPTH = 2;
constexpr int NGU = 2 * DFF;
constexpr int NPROJ = 2816;
constexpr int DINP = 2568;
constexpr int PC_Z = 0, PC_XBC = 512, PC_Q = 1536, PC_K = 1792, PC_V = 1920, PC_U = 2048, PC_GV = 2304, PC_DT = 2560;
constexpr int NCH = 32;
constexpr float EPS = 1e-6f;
constexpr size_t MiB = 1u << 20;
constexpr size_t WS_BAR = 65536, WS_CD = 0, WS_SSQ = 89 * MiB, WS_MSSQ = 3 * MiB, WS_DTRAW = 5 * MiB, WS_SGUW = 6 * MiB, WS_W = 8 * MiB;
constexpr size_t WL_GU1 = 0, WL_D1 = 11 * MiB, WL_IN = WL_D1 + 5632 * 1024, WL_OUT = WL_IN + 5632 * 1024, WL_GU2 = WL_OUT + 2 * MiB, WL_D2 = WL_GU2 + 11 * MiB, WL_SIZE = WL_D2 + 5632 * 1024;
constexpr size_t WS_XB = 96 * MiB, WS_ST = 96 * MiB, WS_ACT = 160 * MiB, WS_YG = 160 * MiB, WS_YCAT = 224 * MiB, WS_PV = 288 * MiB, WS_PROJ = 336 * MiB, WS_END = 512 * MiB;
static_assert(WS_W + 2 * WL_SIZE <= WS_XB, "weights fit");
constexpr int LDS_BYTES = 147456;
#ifndef PH
#define PH 2047
#endif

__device__ const unsigned char T5_BUCKET[128] = {0,1,2,3,4,5,6,7,8,9,10,11,12,13,14,15,16,16,16,17,17,18,18,18,19,19,19,20,20,20,20,21,21,21,21,22,22,22,22,22,23,23,23,23,23,23,24,24,24,24,24,24,25,25,25,25,25,25,25,26,26,26,26,26,26,26,26,27,27,27,27,27,27,27,27,27,27,28,28,28,28,28,28,28,28,28,28,29,29,29,29,29,29,29,29,29,29,29,29,30,30,30,30,30,30,30,30,30,30,30,30,30,30,31,31,31,31,31,31,31,31,31,31,31,31,31,31,31};

DI float bf2f(unsigned short b) { return __uint_as_float((unsigned)b << 16); }
typedef float f32x2_t __attribute__((ext_vector_type(2)));
typedef __bf16 bf16x2_t __attribute__((ext_vector_type(2)));
DI unsigned pk2(float lo, float hi) { const f32x2_t v = {lo, hi}; const bf16x2_t b = __builtin_convertvector(v, bf16x2_t); return __builtin_bit_cast(unsigned, b); }
DI unsigned short f2bf(float f) { return (unsigned short)(pk2(f, 0.f) & 0xffffu); }
DI void unpack8(u32x4 r, float (&v)[8]) {
    v[0] = __uint_as_float(r.x << 16); v[1] = __uint_as_float(r.x & 0xffff0000u); v[2] = __uint_as_float(r.y << 16); v[3] = __uint_as_float(r.y & 0xffff0000u);
    v[4] = __uint_as_float(r.z << 16); v[5] = __uint_as_float(r.z & 0xffff0000u); v[6] = __uint_as_float(r.w << 16); v[7] = __uint_as_float(r.w & 0xffff0000u);
}
DI u32x4 pack8(const float (&v)[8]) { u32x4 r; r.x = pk2(v[0], v[1]); r.y = pk2(v[2], v[3]); r.z = pk2(v[4], v[5]); r.w = pk2(v[6], v[7]); return r; }
DI float fast_sigmoid(float x) { return __builtin_amdgcn_rcpf(1.f + __builtin_amdgcn_exp2f(-1.4426950409f * x)); }
DI float silu_f(float x) { return x * fast_sigmoid(x); }
DI float gelu_f(float x) { const float u = 1.5957691216f * (x + 0.044715f * x * x * x); return x * fast_sigmoid(u); }
DI int opaque_tid() { int t; asm volatile("v_mov_b32 %0, %1" : "=v"(t) : "v"((int)threadIdx.x)); return t; }
#define PHASE_IDS() const int tid = opaque_tid(), lane = tid & 63, r16 = lane & 15, q4 = lane >> 4; (void)r16; (void)q4; (void)tid
DI bool lane0_() { return (opaque_tid() & 63) == 0; }
DI float wave_sum(float v) {
#pragma unroll
    for (int o = 1; o < 64; o <<= 1) v += __shfl_xor(v, o);
    return v;
}
DI float sum16(float v) { v += __shfl_xor(v, 1); v += __shfl_xor(v, 2); v += __shfl_xor(v, 4); v += __shfl_xor(v, 8); return v; }
DI float max16(float v) { v = fmaxf(v, __shfl_xor(v, 1)); v = fmaxf(v, __shfl_xor(v, 2)); v = fmaxf(v, __shfl_xor(v, 4)); v = fmaxf(v, __shfl_xor(v, 8)); return v; }
DI f32x4 mfma16(bf16x8 a, bf16x8 b, f32x4 c) { return __builtin_amdgcn_mfma_f32_16x16x32_bf16(a, b, c, 0, 0, 0); }
DI bf16x8 lds_frag(const LAS bf16* base, int row, int stride, int k) { return *(const LAS bf16x8*)(base + row * stride + k); }
DI float rstd4(f32x4 p) { return rsqrtf(((p.x + p.y) + (p.z + p.w)) * (1.f / DM) + EPS); }
DI float row_rstd(const float* ssq, unsigned row) { return rstd4(*(const f32x4*)(ssq + row * 4u)); }

using pg8::Unit;
DI void cached_rs8(float (&rs8)[8], const float* ssq, LAS float* rtab, const Unit& u, int wr, int wc, int fr, int fq) {
    LAS float* tab = rtab + (wr * 4 + wc) * 132;
    LAS int* tag = (LAS int*)(tab + 128);
    const int ln = fq * 16 + fr;
    if (tag[0] != u.pm) {
#pragma unroll
        for (int hh = 0; hh < 2; ++hh) { const int k = ln + 64 * hh; const unsigned row = u.pm * 256 + (k >> 6) * 128 + wr * 64 + ((k >> 4) & 3) * 16 + (k & 15);
            tab[k] = rstd4(*(const f32x4*)(ssq + row * 4u)); }
        if (ln == 0) tag[0] = u.pm;
    }
#pragma unroll
    for (int k = 0; k < 8; ++k) rs8[k] = tab[(k >> 2) * 64 + (k & 3) * 16 + fr];
}

struct EpiSwiglu {
    static constexpr bool PERM = true, AFTER_DRAIN = false;
    bf16* O; const float* ssq; LAS float* rtab;
    DI void operator()(const f32x4 (&acc)[2][2][4][2], const Unit& u, int wr, int wc, int fr, int fq) const {
        const unsigned row0 = u.pm * 256 + wr * 64 + fr; const unsigned col0 = u.pn * 128 + wc * 32 + 8 * fq;
        float rs8[8]; cached_rs8(rs8, ssq, rtab, u, wr, wc, fr, fq);
        unsigned row = row0;
#pragma unroll
        for (int ai = 0; ai < 2; ++ai) {
#pragma unroll
            for (int m = 0; m < 4; ++m) {
                const float rs = rs8[ai * 4 + m];
                float h[8];
#pragma unroll
                for (int n = 0; n < 2; ++n)
#pragma unroll
                    for (int i = 0; i < 4; ++i) { const float g = acc[ai][0][m][n][i] * rs, uu = acc[ai][1][m][n][i] * rs; h[n * 4 + i] = g * uu * fast_sigmoid(g); }
                *(u32x4*)(O + (row * (unsigned)DFF + col0)) = pack8(h);
                asm volatile("" : "+v"(row));
                row += 16;
            }
            row += 64;
        }
    }
};
struct EpiResid {
    static constexpr bool PERM = true, AFTER_DRAIN = false;
    bf16* xb; float* ssq; float alpha; LAS float* red;
    DI void operator()(const f32x4 (&acc)[2][2][4][2], const Unit& u, int wr, int wc, int fr, int fq) const {
        unsigned row = u.pm * 256 + wr * 64 + fr; const unsigned col0 = u.pn * 256 + wc * 32 + 8 * fq;
#pragma unroll
        for (int ai = 0; ai < 2; ++ai) {
            u32x4 bv[4][2];
#pragma unroll
            for (int m = 0; m < 4; ++m)
#pragma unroll
                for (int bj = 0; bj < 2; ++bj) bv[m][bj] = *(const u32x4*)(xb + ((row + 16 * m) * (unsigned)DM + col0 + bj * 128));
#pragma unroll
            for (int m = 0; m < 4; ++m) {
                float ss = 0.f; const unsigned off0 = row * (unsigned)DM + col0;
#pragma unroll
                for (int bj = 0; bj < 2; ++bj) {
                    float o[8]; unpack8(bv[m][bj], o);
#pragma unroll
                    for (int n = 0; n < 2; ++n)
#pragma unroll
                        for (int i = 0; i < 4; ++i) { o[n * 4 + i] += acc[ai][bj][m][n][i] * alpha; ss += o[n * 4 + i] * o[n * 4 + i]; }
                    *(u32x4*)(xb + (off0 + bj * 128)) = pack8(o);
                }
                ss += __shfl_xor(ss, 16); ss += __shfl_xor(ss, 32);
                if (fq == 0) red[(ai * 128 + wr * 64 + m * 16 + fr) * 4 + wc] = ss;
                asm volatile("" : "+v"(row));
                row += 16;
            }
            asm volatile("" ::: "memory");
            row += 64;
        }
        asm volatile("s_waitcnt lgkmcnt(0)" ::: "memory"); __builtin_amdgcn_s_barrier(); asm volatile("" ::: "memory");
        const int t = (wr * 4 + wc) * 64 + fq * 16 + fr;
        if (t < 256) { const f32x4 p = *(const LAS f32x4*)(red + t * 4); ssq[(u.pm * 256 + t) * 4u + u.pn] = (p.x + p.y) + (p.z + p.w); }
    }
};
struct EpiProj {
    static constexpr bool PERM = true, AFTER_DRAIN = false;
    bf16* O; const float* ssq; LAS float* rtab;
    DI void operator()(const f32x4 (&acc)[2][2][4][2], const Unit& u, int wr, int wc, int fr, int fq) const {
        const unsigned row0 = u.pm * 256 + wr * 64 + fr; const unsigned col0 = u.pn * 256 + wc * 32 + 8 * fq;
        float rs8[8]; cached_rs8(rs8, ssq, rtab, u, wr, wc, fr, fq);
        unsigned row = row0;
#pragma unroll
        for (int ai = 0; ai < 2; ++ai) {
#pragma unroll
            for (int m = 0; m < 4; ++m) {
                const float rs = rs8[ai * 4 + m];
#pragma unroll
                for (int bj = 0; bj < 2; ++bj) {
                    float h[8];
#pragma unroll
                    for (int n = 0; n < 2; ++n)
#pragma unroll
                        for (int i = 0; i < 4; ++i) h[n * 4 + i] = acc[ai][bj][m][n][i] * rs;
                    *(u32x4*)(O + (row * (unsigned)NPROJ + col0 + bj * 128)) = pack8(h);
                }
                asm volatile("" : "+v"(row));
                row += 16;
            }
            row += 64;
        }
    }
};

DI const float* src_col(int kind, const float* g, const float* u, int n) {
    if (kind == 0) return g + n;
    if (kind == 1) { const int t = n >> 8, w = n & 255; return (w < 128) ? g + 128 * t + w : u + 128 * t + (w - 128); }
    if (n < 1536) return g + n;
    if (n < 2560) return g + n + 8;
    if (n < 2568) return g + 1536 + (n - 2560);
    return nullptr;
}
DI void transpose_item(int kind, const float* g, const float* u, int ldn, int K, int Np, const float* kscale, bf16* WT, LAS float* scr, int item, int lane) {
    const int nblk = Np / 32, kb = item / nblk, nb = item % nblk, k0 = 64 * kb, n0 = 32 * nb;
    const float* colp = src_col(kind, g, u, n0 + (lane & 31));
    float v[32];
    if (colp) {
        const float* p = colp + (size_t)(k0 + (lane >> 5)) * ldn;
#pragma unroll
        for (int i = 0; i < 32; ++i) v[i] = p[(size_t)(2 * i) * ldn];
    } else {
#pragma unroll
        for (int i = 0; i < 32; ++i) v[i] = 0.f;
    }
#pragma unroll
    for (int i = 0; i < 32; ++i) scr[(2 * i + (lane >> 5)) * 33 + (lane & 31)] = v[i];
    asm volatile("s_waitcnt lgkmcnt(0)" ::: "memory");
    const int c = lane & 7;
    float ks[8];
    if (kscale) { const f32x4 a = *(const f32x4*)(kscale + k0 + 8 * c), b2 = *(const f32x4*)(kscale + k0 + 8 * c + 4); ks[0] = a.x; ks[1] = a.y; ks[2] = a.z; ks[3] = a.w; ks[4] = b2.x; ks[5] = b2.y; ks[6] = b2.z; ks[7] = b2.w; }
    else {
#pragma unroll
        for (int i = 0; i < 8; ++i) ks[i] = 1.f;
    }
#pragma unroll
    for (int j = 0; j < 4; ++j) { const int n = (lane >> 3) + 8 * j; const LAS float* sp = scr + (8 * c) * 33 + n;
        u32x4 o; o.x = pk2(sp[0 * 33] * ks[0], sp[1 * 33] * ks[1]); o.y = pk2(sp[2 * 33] * ks[2], sp[3 * 33] * ks[3]); o.z = pk2(sp[4 * 33] * ks[4], sp[5 * 33] * ks[5]); o.w = pk2(sp[6 * 33] * ks[6], sp[7 * 33] * ks[7]);
        *(u32x4*)(WT + (size_t)(n0 + n) * K + k0 + 8 * c) = o; }
    asm volatile("s_waitcnt lgkmcnt(0)" ::: "memory");
}

DI void conv_load(u32x4 (&Rraw)[19], f32x4 (&Rw)[8], f32x4 (&Rb)[2], const bf16* __restrict__ proj, const float* __restrict__ cw, const float* __restrict__ cb, int pcol, size_t grow0, int c, int l0) {
    const int ch = pcol - PC_XBC;
    const bf16* p = proj + grow0 * NPROJ + pcol;
#pragma unroll
    for (int r = 0; r < 19; ++r) { const int l = l0 - 3 + r; Rraw[r] = (c == 0 && l < 0) ? (u32x4){0u, 0u, 0u, 0u} : *(const u32x4*)(p + (long)l * NPROJ); }
#pragma unroll
    for (int j = 0; j < 4; ++j) { Rw[2 * j] = *(const f32x4*)(cw + j * 1024 + ch); Rw[2 * j + 1] = *(const f32x4*)(cw + j * 1024 + ch + 4); }
    Rb[0] = *(const f32x4*)(cb + ch); Rb[1] = *(const f32x4*)(cb + ch + 4);
}
template <class F>
DI void conv_apply(const u32x4 (&Rraw)[19], const f32x4 (&Rw)[8], const f32x4 (&Rb)[2], int l0, F f) {
    float w[4][8], bias[8];
#pragma unroll
    for (int j = 0; j < 4; ++j)
#pragma unroll
        for (int i = 0; i < 4; ++i) { w[j][i] = Rw[2 * j][i]; w[j][4 + i] = Rw[2 * j + 1][i]; }
#pragma unroll
    for (int i = 0; i < 4; ++i) { bias[i] = Rb[0][i]; bias[4 + i] = Rb[1][i]; }
    float x0[8], x1[8], x2[8], x3[8];
    unpack8(Rraw[0], x0); unpack8(Rraw[1], x1); unpack8(Rraw[2], x2);
#pragma unroll
    for (int r = 0; r < 16; ++r) {
        unpack8(Rraw[r + 3], x3);
        float o[8];
#pragma unroll
        for (int i = 0; i < 8; ++i) { const float y = bias[i] + w[0][i] * x0[i] + w[1][i] * x1[i] + w[2][i] * x2[i] + w[3][i] * x3[i]; o[i] = silu_f(y); }
        f(l0 + r, o);
#pragma unroll
        for (int i = 0; i < 8; ++i) { x0[i] = x1[i]; x1[i] = x2[i]; x2[i] = x3[i]; }
        __builtin_amdgcn_sched_barrier(0);
    }
}

DI void ssd_dt_acs_wave(float x0, float x1, float negA, LAS float* s_dt, LAS float* s_acs, int lane) {
    const float d0 = (x0 > 20.f) ? x0 : log1pf(__expf(x0)), d1 = (x1 > 20.f) ? x1 : log1pf(__expf(x1));
    const float a0 = d0 * negA, a1 = d1 * negA;
    float sc = a0 + a1;
#pragma unroll
    for (int o = 1; o < 64; o <<= 1) { const float t = __shfl_up(sc, o); if (lane >= o) sc += t; }
    s_dt[2 * lane] = d0; s_dt[2 * lane + 1] = d1; s_acs[2 * lane] = sc - a1; s_acs[2 * lane + 1] = sc;
}

#define XB_TMO      128
#define XB_XCNT(j)  (256  + 64 * (j))
#define XB_XSUB(j)  (1280 + 64 * (j))
#define XB_XGEN(j)  (2304 + 64 * (j))
#define XB_TOP      3328
#define XB_TOPGEN   3392
#define XCD_BAR_WORDS 3456
#define XB_SPIN_CAP (1u << 18)

__device__ __forceinline__ unsigned xb_ld(unsigned* p)              { return __hip_atomic_load(p, __ATOMIC_RELAXED, __HIP_MEMORY_SCOPE_AGENT); }
__device__ __forceinline__ unsigned xb_add(unsigned* p, unsigned v) { return __hip_atomic_fetch_add(p, v, __ATOMIC_RELAXED, __HIP_MEMORY_SCOPE_AGENT); }
__device__ __forceinline__ unsigned xb_xcc_id() { return (unsigned)__builtin_amdgcn_s_getreg((3 << 11) | 20) & 0xFu; }
#define XB_SPIN(cond, bar) do { unsigned _sp = 0; while (cond) { __builtin_amdgcn_s_sleep(1); \
    if ((++_sp & 255u) == 0u) { if (xb_ld(&(bar)[XB_TMO])) break; if (_sp > XB_SPIN_CAP) { atomicAdd(&(bar)[XB_TMO], 1u); break; } } } } while (0)

struct XcdBarrier {
    unsigned* bar; unsigned x;
    volatile LAS unsigned* st;
};

__device__ __forceinline__ XcdBarrier xcd_barrier_post(unsigned* bar, volatile LAS unsigned* st) {
    XcdBarrier b; b.bar = bar; b.x = xb_xcc_id(); b.st = st;
    if (threadIdx.x == 0) (void)xb_add(&bar[XB_XCNT(b.x)], 1u);
    return b;
}
__device__ __forceinline__ void xcd_barrier_complete(unsigned* bar, unsigned x, unsigned& nloc, unsigned& nx) {
    const unsigned G = gridDim.x * gridDim.y * gridDim.z;
    unsigned sum, cnt, mine, sp = 0u;
    for (;;) {
        sum = 0u; cnt = 0u; mine = 0u;
#pragma unroll
        for (unsigned j = 0; j < 16; ++j) { const unsigned c = xb_ld(&bar[XB_XCNT(j)]); sum += c; cnt += (c > 0u) ? 1u : 0u; mine = (j == x) ? c : mine; }
        if (sum == G) break;
        __builtin_amdgcn_s_sleep(1);
        if ((++sp & 255u) == 0u) { if (xb_ld(&bar[XB_TMO])) break; if (sp > XB_SPIN_CAP) { atomicAdd(&bar[XB_TMO], 1u); break; } }
    }
    nloc = mine > 0u ? mine : 1u; nx = cnt > 0u ? cnt : 1u;
}

__device__ __forceinline__ void xcd_barrier(const XcdBarrier& b) {
    asm volatile("s_waitcnt vmcnt(0)" ::: "memory");
    __syncthreads();
    if (threadIdx.x == 0) {
        unsigned* bar = b.bar;
        __builtin_amdgcn_s_waitcnt(0);
        unsigned nloc = b.st[0], nx = b.st[1];
        if (nloc == 0u) { xcd_barrier_complete(bar, b.x, nloc, nx); b.st[0] = nloc; b.st[1] = nx; }
        const unsigned old = xb_add(&bar[XB_XSUB(b.x)], 1u);
        const unsigned gen = old / nloc;
        if (old + 1u == (gen + 1u) * nloc) {
            __builtin_amdgcn_fence(__ATOMIC_RELEASE, "agent");
            asm volatile("s_waitcnt vmcnt(0)" ::: "memory");
            const unsigned og = xb_add(&bar[XB_TOP], 1u);
            const unsigned tg = og / nx;
            if (og + 1u == (tg + 1u) * nx) xb_add(&bar[XB_TOPGEN], 1u);
            else XB_SPIN(xb_ld(&bar[XB_TOPGEN]) == tg, bar);
            __builtin_amdgcn_fence(__ATOMIC_ACQUIRE, "agent");
            xb_add(&bar[XB_XGEN(b.x)], 1u);
            asm volatile("s_waitcnt vmcnt(0)" ::: "memory");
        } else {
            XB_SPIN(xb_ld(&bar[XB_XGEN(b.x)]) == gen, bar);
            __builtin_amdgcn_fence(__ATOMIC_ACQUIRE, "agent");
            asm volatile("s_waitcnt vmcnt(0)" ::: "memory");
        }
    }
    __syncthreads();
}

struct Args { const float* in[27]; float* out; unsigned char* ws; };

__global__ void __launch_bounds__(512, 2) fwd_megakernel(Args args) {
    extern __shared__ __attribute__((aligned(16))) unsigned char lds_raw[];
    LAS unsigned char* lds = (LAS unsigned char*)lds_raw;
    cg::grid_group grid = cg::this_grid();
    if (args.ws == nullptr) grid.sync();
    volatile LAS unsigned* bst = (volatile LAS unsigned*)(lds + 147440);
    if (threadIdx.x < 4) bst[threadIdx.x] = 0u;
    __syncthreads();
    (void)xcd_barrier_post((unsigned*)(args.ws + WS_BAR), bst);
#define GRID_SYNC() do { XcdBarrier b_; b_.bar = (unsigned*)(args.ws + WS_BAR); b_.x = xb_xcc_id(); b_.st = (volatile LAS unsigned*)(lds + 147440); xcd_barrier(b_); } while (0)
    const int wave = __builtin_amdgcn_readfirstlane((int)threadIdx.x >> 6);
    const int G = gridDim.x, bid = blockIdx.x;
    const int gw = bid * 8 + wave, NGW = G * 8;
    unsigned char* ws = args.ws;
    float* ssq = (float*)(ws + WS_SSQ);     float* mss_g = (float*)(ws + WS_MSSQ);   float* mss_a = mss_g + (size_t)2 * MTOK * 4;   float* dtraw = (float*)(ws + WS_DTRAW); float* CD = (float*)(ws + WS_CD);
    bf16* sguW = (bf16*)(ws + WS_SGUW);
    bf16* xb = (bf16*)(ws + WS_XB); float* ST = args.out;     bf16* actb = (bf16*)(ws + WS_ACT); bf16* Yg = (bf16*)(ws + WS_YG); bf16* ycat = (bf16*)(ws + WS_YCAT);
    bf16* PV = (bf16*)(ws + WS_PV); bf16* proj = (bf16*)(ws + WS_PROJ);

#if PH & 1
#ifndef PROREP
#define PROREP 1
#endif
#ifndef SYNCREP
#define SYNCREP 0
#endif
    for (int rep_ = 0; rep_ < SYNCREP; ++rep_) GRID_SYNC();
    for (int rep_ = 0; rep_ < PROREP; ++rep_) {
        PHASE_IDS();
        LAS float* scr = (LAS float*)(lds + wave * 16384);
        for (int mi = 0; mi < 12; ++mi) {
            const int l = mi / 6, t = mi % 6;
            const float* g; const float* u = nullptr; const float* ks = nullptr; int kind = 0, ldn, K, Np; bf16* WT = (bf16*)(ws + WS_W + (size_t)l * WL_SIZE);
            if (t == 0)      { g = args.in[2] + (size_t)l * DM * DFF; u = args.in[3] + (size_t)l * DM * DFF; ks = args.in[1] + l * DM; kind = 1; ldn = DFF; K = DM; Np = NGU; WT += WL_GU1 / 2; }
            else if (t == 1) { g = args.in[4] + (size_t)l * DFF * DM; ldn = DM; K = DFF; Np = DM; WT += WL_D1 / 2; }
            else if (t == 2) { g = args.in[6] + (size_t)l * DM * DINP; ks = args.in[5] + l * DM; kind = 2; ldn = DINP; K = DM; Np = NPROJ; WT += WL_IN / 2; }
            else if (t == 3) { g = args.in[21] + (size_t)l * DM * DM; ldn = DM; K = DM; Np = DM; WT += WL_OUT / 2; }
            else if (t == 4) { g = args.in[23] + (size_t)l * DM * DFF; u = args.in[24] + (size_t)l * DM * DFF; ks = args.in[22] + l * DM; kind = 1; ldn = DFF; K = DM; Np = NGU; WT += WL_GU2 / 2; }
            else             { g = args.in[25] + (size_t)l * DFF * DM; ldn = DM; K = DFF; Np = DM; WT += WL_D2 / 2; }
            const int nitems = (K / 64) * (Np / 32);
            for (int it = gw; it < nitems; it += NGW) transpose_item(kind, g, u, ldn, K, Np, ks, WT, scr, it, lane);
        }
        for (int i = bid * 512 + tid; i < DEPTH * 4 * 128 * 128; i += G * 512) { const int t = (i >> 7) & 127, s = i & 127; sguW[i] = f2bf(s <= t ? args.in[18][i] : 0.f); }
        const float* x = args.in[0];
        for (int m0 = gw; m0 < MTOK; m0 += 4 * NGW) {
            f32x4 v[4][4];
#pragma unroll
            for (int r = 0; r < 4; ++r) { const int m = min(m0 + r * NGW, MTOK - 1); const f32x4* xr = (const f32x4*)(x + (size_t)m * DM) + 2 * lane;
#pragma unroll
                for (int j = 0; j < 2; ++j) { v[r][2 * j] = xr[128 * j]; v[r][2 * j + 1] = xr[128 * j + 1]; } }
#pragma unroll
            for (int r = 0; r < 4; ++r) { const int m = m0 + r * NGW; if (m < MTOK) {
                float sq = 0.f; u32x4* o16 = (u32x4*)(xb + (size_t)m * DM) + lane;
#pragma unroll
                for (int j = 0; j < 2; ++j) { const f32x4 t = v[r][2 * j], t2 = v[r][2 * j + 1];
                    sq += ((t.x * t.x + t.y * t.y) + (t.z * t.z + t.w * t.w)) + ((t2.x * t2.x + t2.y * t2.y) + (t2.z * t2.z + t2.w * t2.w));
                    u32x4 w; w.x = pk2(t.x, t.y); w.y = pk2(t.z, t.w); w.z = pk2(t2.x, t2.y); w.w = pk2(t2.z, t2.w); o16[64 * j] = w; }
                sq = wave_sum(sq);
                if (lane == 0) *(f32x4*)(ssq + (size_t)m * 4) = (f32x4){sq, 0.f, 0.f, 0.f}; } }
        }
    }
#endif
    GRID_SYNC();

    for (int layer = 0; layer < DEPTH; ++layer) {
        const bf16* Wl = (const bf16*)(ws + WS_W + (size_t)layer * WL_SIZE);
        for (int half = 0; half < 2; ++half) {
#if PH & 2
#ifndef UPREP
#define UPREP 1
#endif
            for (int rep_ = 0; rep_ < UPREP; ++rep_) {
                pg8::Gemm g{xb, Wl + (half ? WL_GU2 : WL_GU1) / 2, MTOK, NGU, DM}; pg8::StaticOrder S; S.init(MTOK, NGU, G, bid);
                if (lane0_()) *(LAS int*)((LAS float*)(lds + 135168) + wave * 132 + 128) = -1;
                EpiSwiglu E{actb, ssq + (size_t)(3 * layer + 2 * half) * MTOK * 4, (LAS float*)(lds + 135168)};
                pg8::gemm_phase<EpiSwiglu, pg8::StaticOrder, true, true>(lds, g, S, E);
            }
            GRID_SYNC();
            {
                pg8::Gemm g{actb, Wl + (half ? WL_D2 : WL_D1) / 2, MTOK, DM, DFF}; pg8::StaticOrder S; S.init(MTOK, DM, G, bid);
                EpiResid E{xb, ssq + (size_t)(3 * layer + 2 * half + 1) * MTOK * 4, 0.5f, (LAS float*)(lds + 131072)};
                pg8::gemm_phase<EpiResid, pg8::StaticOrder, true, true>(lds, g, S, E);
            }
            GRID_SYNC();
            if (half == 1) break;

#endif
#if PH & 4
            {
                pg8::Gemm g{xb, Wl + WL_IN / 2, MTOK, 2560, DM}; pg8::StaticOrder S; S.init(MTOK, 2560, G, bid);
                if (lane0_()) *(LAS int*)((LAS float*)(lds + 135168) + wave * 132 + 128) = -1;
                EpiProj E{proj, ssq + (size_t)(3 * layer + 1) * MTOK * 4, (LAS float*)(lds + 135168)};
                pg8::gemm_phase<EpiProj, pg8::StaticOrder, true, true>(lds, g, S, E);
            }
            {
                PHASE_IDS();
                const float* ssq_in = ssq + (size_t)(3 * layer + 1) * MTOK * 4;
                const bf16* wdt = Wl + WL_IN / 2 + (size_t)(2560 + r16) * DM + q4 * 8;
                for (int rb = gw; rb < MTOK / 16; rb += NGW) {
                    const bf16* xa = xb + (size_t)(rb * 16 + r16) * DM + q4 * 8;
                    f32x4 acc = (f32x4){0.f, 0.f, 0.f, 0.f};
#pragma unroll 8
                    for (int ks = 0; ks < 32; ++ks) acc = mfma16(*(const bf16x8*)(xa + ks * 32), *(const bf16x8*)(wdt + ks * 32), acc);
                    if (r16 < 8) {
#pragma unroll
                        for (int j = 0; j < 4; ++j) { const unsigned row = rb * 16 + q4 * 4 + j; dtraw[row * 8u + r16] = acc[j] * row_rstd(ssq_in, row); }
                    }
                }
            }
            GRID_SYNC();

            const float* conv_w = args.in[7] + layer * 4 * 1024; const float* conv_b = args.in[8] + layer * 1024;
#endif
#ifndef MIXREP
#define MIXREP 1
#endif
#ifndef REPMASK
#define REPMASK 0
#endif
            for (int rep_ = 0; rep_ < MIXREP; ++rep_) {
#if PH & 8
            for (int rp_ = 0; rp_ < ((REPMASK & 8) ? 2 : 1); ++rp_)
            for (int unit = bid; unit < BATCH * NCH * 2; unit += G) {
                PHASE_IDS();
                const int g2 = unit & 1, c = (unit >> 1) & 31, b = unit >> 6;
                const size_t grow0 = (size_t)b * SEQ + c * 128;
                LAS bf16* xT = (LAS bf16*)lds;
                LAS bf16* BTs = (LAS bf16*)(lds + 69632);
                LAS float* s_dt = (LAS float*)(lds + 104448); LAS float* s_acs = s_dt + 512;
                u32x4 Rraw[19]; f32x4 Rw[8]; f32x4 Rb[2]; float dx[4] = {0.f, 0.f, 0.f, 0.f};
#pragma unroll
                for (int i = 0; i < 19; ++i) Rraw[i] = (u32x4){0u, 0u, 0u, 0u};
#pragma unroll
                for (int i = 0; i < 8; ++i) Rw[i] = (f32x4){0.f, 0.f, 0.f, 0.f};
                Rb[0] = (f32x4){0.f, 0.f, 0.f, 0.f}; Rb[1] = (f32x4){0.f, 0.f, 0.f, 0.f};
                const int cgi = tid >> 3, l0 = (tid & 7) * 16;
                if (wave < 4) conv_load(Rraw, Rw, Rb, proj, conv_w, conv_b, PC_XBC + g2 * 256 + cgi * 8, grow0, c, l0);
                else if (wave < 6) conv_load(Rraw, Rw, Rb, proj, conv_w, conv_b, PC_XBC + 512 + g2 * 128 + (cgi - 32) * 8, grow0, c, l0);
                else {
#pragma unroll
                    for (int k = 0; k < 2; ++k) { const int h = g2 * 4 + (wave - 6) * 2 + k; const float dtb = args.in[9][layer * 8 + h];
                        dx[2 * k] = dtraw[(grow0 + 2 * lane) * 8 + h] + dtb; dx[2 * k + 1] = dtraw[(grow0 + 2 * lane + 1) * 8 + h] + dtb; }
#pragma unroll
                    for (int k = 0; k < 2; ++k) { const int hh = (wave - 6) * 2 + k; ssd_dt_acs_wave(dx[2 * k], dx[2 * k + 1], -__expf(args.in[10][layer * 8 + g2 * 4 + hh]), s_dt + hh * 128, s_acs + hh * 128, lane); }
                }
                __syncthreads();
                if (wave < 4) {
                    const int hh = cgi >> 3, pl = (cgi & 7) * 8; const float acs_end = s_acs[hh * 128 + 127];
                    LAS bf16* dst = xT + hh * (64 * 136);
                    conv_apply(Rraw, Rw, Rb, l0, [&](int l, const float (&o)[8]) {
                        const float sc = s_dt[hh * 128 + l] * __expf(acs_end - s_acs[hh * 128 + l]);
#pragma unroll
                        for (int i = 0; i < 8; ++i) dst[(pl + i) * 136 + l] = f2bf(o[i] * sc); });
                } else if (wave < 6) {
                    const int nl = (cgi - 32) * 8;
                    conv_apply(Rraw, Rw, Rb, l0, [&](int l, const float (&o)[8]) {
#pragma unroll
                        for (int i = 0; i < 8; ++i) BTs[(nl + i) * 136 + l] = f2bf(o[i]); });
                }
                __syncthreads();
                {
                    bf16x8 bfr[4];
#pragma unroll
                    for (int ks = 0; ks < 4; ++ks) bfr[ks] = lds_frag(BTs, 16 * wave + r16, 136, ks * 32 + q4 * 8);
#pragma unroll
                    for (int hh = 0; hh < 4; ++hh) {
                        f32x4 acc[4];
#pragma unroll
                        for (int pt = 0; pt < 4; ++pt) acc[pt] = (f32x4){0.f, 0.f, 0.f, 0.f};
#pragma unroll
                        for (int ks = 0; ks < 4; ++ks)
#pragma unroll
                            for (int pt = 0; pt < 4; ++pt) acc[pt] = mfma16(bfr[ks], lds_frag(xT + hh * (64 * 136), 16 * pt + r16, 136, ks * 32 + q4 * 8), acc[pt]);
                        const int unit8 = ((b * NCH + c) * 8) + g2 * 4 + hh;
                        float* st = ST + (size_t)unit8 * 8192;
#pragma unroll
                        for (int pt = 0; pt < 4; ++pt) *(f32x4*)(st + (16 * pt + r16) * 128 + 16 * wave + q4 * 4) = acc[pt];
                    }
                }
                if (tid < 4) CD[((b * NCH + c) * 2 + g2) * 32 + tid] = __expf(s_acs[tid * 128 + 127]);
                __syncthreads();
            }
#endif
#if PH & 16
            for (int rp_ = 0; rp_ < ((REPMASK & 16) ? 2 : 1); ++rp_)
            for (int unit = bid; unit < BATCH * NCH; unit += G) {
                PHASE_IDS();
                const int nb = unit & 31, b = unit >> 5;
                const size_t grow0 = (size_t)b * SEQ + nb * 128;
                LAS bf16* Ks = (LAS bf16*)lds; LAS bf16* VT = (LAS bf16*)(lds + 36864); LAS bf16* Ps = (LAS bf16*)(lds + 72704) + wave * (16 * 168);
                LAS float* s_bias = (LAS float*)(lds + 115712);
                s_bias[tid] = args.in[14][T5_BUCKET[tid & 127] * 4 + (tid >> 7)];
                for (int it = tid; it < 64 * 24; it += 512) { const int d = it / 24, j = 256 + it % 24; VT[d * 280 + j] = 0; }
                f32x4 og[4][4]; float ssr[4] = {0.f, 0.f, 0.f, 0.f};
#pragma unroll
                for (int kvh = 0; kvh < 2; ++kvh) {
                    if (kvh) __syncthreads();
                    {
                        u32x4 kq[4], vq[4];
#pragma unroll
                        for (int k = 0; k < 4; ++k) {
                            const int it = tid + 512 * k, j = it >> 3, d8 = (it & 7) * 8;
                            kq[k] = (u32x4){0u, 0u, 0u, 0u}; vq[k] = (u32x4){0u, 0u, 0u, 0u};
                            if (nb > 0 || j >= 128) { const bf16* src = proj + (grow0 + j - 128) * NPROJ + kvh * 64 + d8; kq[k] = *(const u32x4*)(src + PC_K); vq[k] = *(const u32x4*)(src + PC_V); }
                        }
#pragma unroll
                        for (int k = 0; k < 4; ++k) {
                            const int it = tid + 512 * k, j = it >> 3, d8 = (it & 7) * 8;
                            *(LAS u32x4*)(Ks + j * 72 + d8) = kq[k];
                            const unsigned vw[4] = {vq[k].x, vq[k].y, vq[k].z, vq[k].w};
#pragma unroll
                            for (int i = 0; i < 4; ++i) { VT[(d8 + 2 * i) * 280 + j] = (bf16)(vw[i] & 0xffffu); VT[(d8 + 2 * i + 1) * 280 + j] = (bf16)(vw[i] >> 16); }
                        }
                    }
                    __syncthreads();
#pragma unroll
                    for (int g = 0; g < 2; ++g) {
                        const int hq = kvh * 2 + g;
                        const float sink = args.in[13][layer * 4 + hq];
                        const bf16* qp = proj + (grow0 + 16 * wave + r16) * NPROJ + PC_Q + hq * 64 + q4 * 8;
                        const bf16x8 aq0 = *(const bf16x8*)qp, aq1 = *(const bf16x8*)(qp + 32);
                        f32x4 sc[9];
#pragma unroll
                        for (int kk = 0; kk < 9; ++kk) {
                            const int krow = 16 * (wave + kk) + r16;
                            f32x4 a = (f32x4){0.f, 0.f, 0.f, 0.f};
                            a = mfma16(aq0, lds_frag(Ks, krow, 72, q4 * 8), a);
                            a = mfma16(aq1, lds_frag(Ks, krow, 72, 32 + q4 * 8), a);
                            sc[kk] = a;
                        }
                        float sm[4];
#pragma unroll
                        for (int j = 0; j < 4; ++j) {
                            const int i = 16 * wave + q4 * 4 + j; float m = -INFINITY;
#pragma unroll
                            for (int kk = 0; kk < 9; ++kk) {
                                const int jk = 16 * (wave + kk) + r16, dist = i - jk + 128;
                                const bool ok = (dist >= 0) && (dist < 128) && (nb > 0 || jk >= 128);
                                const float sv = ok ? sc[kk][j] * 0.125f + s_bias[hq * 128 + (dist & 127)] : -INFINITY;
                                sc[kk][j] = sv; m = fmaxf(m, sv);
                            }
                            m = fmaxf(max16(m), sink);
                            float su = 0.f;
#pragma unroll
                            for (int kk = 0; kk < 9; ++kk) { const float p = __expf(sc[kk][j] - m); sc[kk][j] = p; su += p; }
                            sm[j] = sum16(su) + __expf(sink - m);
                        }
#pragma unroll
                        for (int kk = 0; kk < 9; ++kk)
#pragma unroll
                            for (int j = 0; j < 4; ++j) Ps[(q4 * 4 + j) * 168 + kk * 16 + r16] = f2bf(sc[kk][j]);
                        *(LAS u32x2*)(Ps + (lane >> 2) * 168 + 144 + (lane & 3) * 4) = (u32x2){0u, 0u};
                        f32x4 oa[4];
#pragma unroll
                        for (int dt = 0; dt < 4; ++dt) oa[dt] = (f32x4){0.f, 0.f, 0.f, 0.f};
#pragma unroll
                        for (int ks = 0; ks < 5; ++ks) {
                            const bf16x8 pa = lds_frag(Ps, r16, 168, ks * 32 + q4 * 8);
#pragma unroll
                            for (int dt = 0; dt < 4; ++dt) oa[dt] = mfma16(pa, lds_frag(VT, 16 * dt + r16, 280, 16 * wave + ks * 32 + q4 * 8), oa[dt]);
                        }
#pragma unroll
                        for (int j = 0; j < 4; ++j) { const float inv = 1.f / sm[j];
#pragma unroll
                            for (int dt = 0; dt < 4; ++dt) { const float o = oa[dt][j] * inv; ssr[j] += o * o; og[hq][dt][j] = o; } }
                    }
                }
#pragma unroll
                for (int hq = 0; hq < 4; ++hq) {
#pragma unroll
                    for (int j = 0; j < 4; ++j) {
                        const size_t row = grow0 + 16 * wave + q4 * 4 + j; float ss = 0.f;
#pragma unroll
                        for (int dt = 0; dt < 4; ++dt) { const float o = og[hq][dt][j]; ss += o * o; Yg[row * DM + 512 + hq * 64 + 16 * dt + r16] = f2bf(o); }
                        ss = sum16(ss);
                        if (r16 == 0) mss_a[(size_t)hq * MTOK + row] = ss;
                    }
                }
                __syncthreads();
            }
#endif
#if PH & 32
            for (int rp_ = 0; rp_ < ((REPMASK & 32) ? 2 : 1); ++rp_)
            for (int unit = bid; unit < BATCH * NCH; unit += G) {
                PHASE_IDS();
                const int c = unit & 31, b = unit >> 5;
                const size_t grow0 = (size_t)b * SEQ + c * 128;
                LAS bf16* vnT = (LAS bf16*)lds;
                LAS bf16* Us = (LAS bf16*)(lds + 69632);
                const int l = tid >> 2, sub = tid & 3;
                u32x4 gvr[8], ur[8]; bf16x8 wa[4][4];
                {
                    const bf16* src = proj + (grow0 + l) * NPROJ + PC_GV + sub * 64;
#pragma unroll
                    for (int k = 0; k < 8; ++k) gvr[k] = *(const u32x4*)(src + 8 * k);
#pragma unroll
                    for (int k = 0; k < 8; ++k) { const int it = tid + 512 * k, t = it >> 5, c8 = (it & 31) * 8; ur[k] = *(const u32x4*)(proj + (grow0 + t) * NPROJ + PC_U + c8); }
                }
                {
                    float v[64]; float sm = 0.f;
#pragma unroll
                    for (int k = 0; k < 8; ++k) { float t8[8]; unpack8(gvr[k], t8);
#pragma unroll
                        for (int i = 0; i < 8; ++i) { v[8 * k + i] = gelu_f(t8[i]); sm += v[8 * k + i]; } }
                    sm += __shfl_xor(sm, 1); sm += __shfl_xor(sm, 2);
                    const float mean = sm * (1.f / 256.f); float qv = 0.f;
#pragma unroll
                    for (int i = 0; i < 64; ++i) { const float d = v[i] - mean; qv += d * d; }
                    qv += __shfl_xor(qv, 1); qv += __shfl_xor(qv, 2);
                    const float rstd = rsqrtf(qv * (1.f / 256.f) + EPS);
                    const float* lw = args.in[16] + layer * 256 + sub * 64; const float* lb = args.in[17] + layer * 256 + sub * 64;
                    LAS bf16* dst = vnT + sub * (64 * 136) + l;
#pragma unroll
                    for (int i = 0; i < 64; ++i) dst[i * 136] = f2bf((v[i] - mean) * rstd * lw[i] + lb[i]);
                }
#pragma unroll
                for (int k = 0; k < 8; ++k) { const int it = tid + 512 * k, t = it >> 5, c8 = (it & 31) * 8; *(LAS u32x4*)(Us + t * 264 + c8) = ur[k]; }
#pragma unroll
                for (int gi = 0; gi < 4; ++gi)
#pragma unroll
                    for (int ks = 0; ks < 4; ++ks) wa[gi][ks] = *(const bf16x8*)(sguW + (size_t)(layer * 4 + gi) * 16384 + (16 * wave + r16) * 128 + ks * 32 + q4 * 8);
                __syncthreads();
                {
                    f32x4 og[4][4]; float ss[4] = {0.f, 0.f, 0.f, 0.f};
#pragma unroll
                    for (int gi = 0; gi < 4; ++gi) {
                        f32x4 acc[4];
#pragma unroll
                        for (int dt = 0; dt < 4; ++dt) acc[dt] = (f32x4){0.f, 0.f, 0.f, 0.f};
#pragma unroll
                        for (int ks = 0; ks < 4; ++ks) {
                            if (2 * ks <= wave) {
#pragma unroll
                                for (int dt = 0; dt < 4; ++dt) acc[dt] = mfma16(wa[gi][ks], lds_frag(vnT + gi * (64 * 136), 16 * dt + r16, 136, ks * 32 + q4 * 8), acc[dt]);
                            }
                        }
#pragma unroll
                        for (int j = 0; j < 4; ++j) {
                            const int t = 16 * wave + q4 * 4 + j; const float bs = args.in[19][(layer * 4 + gi) * 128 + t];
#pragma unroll
                            for (int dt = 0; dt < 4; ++dt) {
                                const float uu = gelu_f(bf2f(Us[t * 264 + gi * 64 + 16 * dt + r16]));
                                const float o = uu * (acc[dt][j] + bs); ss[j] += o * o; og[gi][dt][j] = o;
                            }
                        }
                    }
                    float rs[4];
#pragma unroll
                    for (int j = 0; j < 4; ++j) rs[j] = rsqrtf(sum16(ss[j]) * (1.f / 256.f) + EPS);
#pragma unroll
                    for (int gi = 0; gi < 4; ++gi)
#pragma unroll
                        for (int dt = 0; dt < 4; ++dt) {
                            const int col = gi * 64 + 16 * dt + r16; const float nw = args.in[20][layer * 256 + col];
#pragma unroll
                            for (int j = 0; j < 4; ++j) ycat[(grow0 + 16 * wave + q4 * 4 + j) * DM + 768 + col] = f2bf(og[gi][dt][j] * rs[j] * nw);
                        }
                }
                __syncthreads();
            }
            GRID_SYNC();
#endif
#if PH & 64
            for (int rp_ = 0; rp_ < ((REPMASK & 64) ? 2 : 1); ++rp_)
            { PHASE_IDS();
            for (int e = bid * 512 + tid; e < BATCH * 8 * 2048; e += G * 512) {
                const int i4 = e & 2047, h = (e >> 11) & 7, b = e >> 14;
                f32x4 carry = (f32x4){0.f, 0.f, 0.f, 0.f};
#pragma unroll 8
                for (int c = 0; c < NCH; ++c) {
                    const int unit = (b * NCH + c) * 8 + h;
                    const f32x4 st = *(const f32x4*)(ST + (size_t)unit * 8192 + i4 * 4); const float dec = CD[((b * NCH + c) * 2 + (h >> 2)) * 32 + (h & 3)];
                    u32x2 w; w.x = pk2(carry.x, carry.y); w.y = pk2(carry.z, carry.w); *(u32x2*)(PV + (size_t)unit * 8192 + i4 * 4) = w;
                    carry = carry * dec + st;
                }
            } }
            GRID_SYNC();
#endif
#if PH & 128
            for (int rp_ = 0; rp_ < ((REPMASK & 128) ? 2 : 1); ++rp_)
            for (int unit = bid; unit < BATCH * NCH * 2; unit += G) {
                PHASE_IDS();
                const int g2 = unit & 1, c = (unit >> 1) & 31, b = unit >> 6;
                const size_t grow0 = (size_t)b * SEQ + c * 128;
                LAS bf16* Cs = (LAS bf16*)lds; LAS bf16* Bs = (LAS bf16*)(lds + 34816); LAS bf16* Ms = Bs;
                LAS bf16* xT = (LAS bf16*)(lds + 69632);
                LAS float* s_dt = (LAS float*)(lds + 139264); LAS float* s_acs = s_dt + 512;
                u32x4 Rraw[19]; f32x4 Rw[8]; f32x4 Rb[2]; float dx0 = 0.f, dx1 = 0.f;
                const int cgi = tid >> 3, l0 = (tid & 7) * 16;
                if (wave < 4) {
                    conv_load(Rraw, Rw, Rb, proj, conv_w, conv_b, PC_XBC + g2 * 256 + cgi * 8, grow0, c, l0);
                    const int h = g2 * 4 + wave; const float dtb = args.in[9][layer * 8 + h];
                    dx0 = dtraw[(grow0 + 2 * lane) * 8 + h] + dtb; dx1 = dtraw[(grow0 + 2 * lane + 1) * 8 + h] + dtb;
                } else if (wave < 6) conv_load(Rraw, Rw, Rb, proj, conv_w, conv_b, PC_XBC + 512 + g2 * 128 + (cgi - 32) * 8, grow0, c, l0);
                else conv_load(Rraw, Rw, Rb, proj, conv_w, conv_b, PC_XBC + 768 + g2 * 128 + (cgi - 48) * 8, grow0, c, l0);
                if (wave < 4) {
                    const int hh = cgi >> 3, pl = (cgi & 7) * 8;
                    LAS bf16* dst = xT + hh * (64 * 136);
                    conv_apply(Rraw, Rw, Rb, l0, [&](int l, const float (&o)[8]) {
#pragma unroll
                        for (int i = 0; i < 8; ++i) dst[(pl + i) * 136 + l] = f2bf(o[i]); });
                    ssd_dt_acs_wave(dx0, dx1, -__expf(args.in[10][layer * 8 + g2 * 4 + wave]), s_dt + wave * 128, s_acs + wave * 128, lane);
                } else if (wave < 6) {
                    const int nl = (cgi - 32) * 8;
                    conv_apply(Rraw, Rw, Rb, l0, [&](int l, const float (&o)[8]) { *(LAS u32x4*)(Bs + l * 136 + nl) = pack8(o); });
                } else {
                    const int nl = (cgi - 48) * 8;
                    conv_apply(Rraw, Rw, Rb, l0, [&](int l, const float (&o)[8]) { *(LAS u32x4*)(Cs + l * 136 + nl) = pack8(o); });
                }
                __syncthreads();
                {
                    const int lrow = 16 * wave + r16;
                    bf16x8 ca[4];
#pragma unroll
                    for (int ks = 0; ks < 4; ++ks) ca[ks] = lds_frag(Cs, lrow, 136, ks * 32 + q4 * 8);
                    f32x4 cbr[8];
#pragma unroll
                    for (int st = 0; st < 8; ++st) {
                        cbr[st] = (f32x4){0.f, 0.f, 0.f, 0.f};
                        if (st <= wave) {
#pragma unroll
                            for (int ks = 0; ks < 4; ++ks) cbr[st] = mfma16(ca[ks], lds_frag(Bs, 16 * st + r16, 136, ks * 32 + q4 * 8), cbr[st]);
                        }
                    }
                    __syncthreads();
#pragma unroll 1
                    for (int hh = 0; hh < 4; ++hh) {
                        const int h = g2 * 4 + hh; const int unit8 = ((b * NCH + c) * 8) + h;
                        bf16x8 pvf[4][4];
                        {
                            const bf16* pv = PV + (size_t)unit8 * 8192;
#pragma unroll
                            for (int ks = 0; ks < 4; ++ks)
#pragma unroll
                                for (int pt = 0; pt < 4; ++pt) pvf[ks][pt] = *(const bf16x8*)(pv + (16 * pt + r16) * 128 + ks * 32 + q4 * 8);
                        }
                        bf16 zr[4][4];
#pragma unroll
                        for (int j = 0; j < 4; ++j)
#pragma unroll
                            for (int pt = 0; pt < 4; ++pt) zr[j][pt] = proj[(grow0 + 16 * wave + q4 * 4 + j) * NPROJ + PC_Z + h * 64 + 16 * pt + r16];
                        const LAS float* hdt = s_dt + hh * 128; const LAS float* hacs = s_acs + hh * 128;
                        float acl[4];
#pragma unroll
                        for (int j = 0; j < 4; ++j) acl[j] = hacs[16 * wave + q4 * 4 + j];
#pragma unroll
                        for (int st = 0; st < 8; ++st) {
                            if (st <= (wave | 1)) {
                                const int sI = 16 * st + r16; const float acss = hacs[sI], dts = hdt[sI];
#pragma unroll
                                for (int j = 0; j < 4; ++j) { const int l = 16 * wave + q4 * 4 + j; const float mv = (sI <= l) ? cbr[st][j] * __expf(fminf(acl[j] - acss, 0.f)) * dts : 0.f; Ms[l * 136 + sI] = f2bf(mv); }
                            }
                        }
                        f32x4 yo[4], yd[4];
#pragma unroll
                        for (int pt = 0; pt < 4; ++pt) { yo[pt] = (f32x4){0.f, 0.f, 0.f, 0.f}; yd[pt] = (f32x4){0.f, 0.f, 0.f, 0.f}; }
                        const LAS bf16* xh = xT + hh * (64 * 136);
#pragma unroll
                        for (int ks = 0; ks < 4; ++ks) {
                            if (2 * ks <= wave) {
                                const bf16x8 ma = lds_frag(Ms, lrow, 136, ks * 32 + q4 * 8);
#pragma unroll
                                for (int pt = 0; pt < 4; ++pt) yd[pt] = mfma16(ma, lds_frag(xh, 16 * pt + r16, 136, ks * 32 + q4 * 8), yd[pt]);
                            }
                        }
#pragma unroll
                        for (int ks = 0; ks < 4; ++ks)
#pragma unroll
                            for (int pt = 0; pt < 4; ++pt) yo[pt] = mfma16(ca[ks], pvf[ks][pt], yo[pt]);
                        const float Dh = args.in[11][layer * 8 + h];
#pragma unroll
                        for (int j = 0; j < 4; ++j) {
                            const int l = 16 * wave + q4 * 4 + j; const size_t row = grow0 + l; const float ea = __expf(acl[j]); float ss = 0.f;
#pragma unroll
                            for (int pt = 0; pt < 4; ++pt) {
                                const int p = 16 * pt + r16;
                                const float y = yd[pt][j] + ea * yo[pt][j] + Dh * bf2f(xh[p * 136 + l]);
                                const float o = y * silu_f(bf2f(zr[j][pt])); ss += o * o; Yg[row * DM + h * 64 + p] = f2bf(o);
                            }
                            ss = sum16(ss);
                            if (r16 == 0) mss_g[((size_t)g2 * MTOK + row) * 4 + hh] = ss;
                        }
                    }
                }
                __syncthreads();
            }
            GRID_SYNC();
#endif
#if PH & 256
            for (int rp_ = 0; rp_ < ((REPMASK & 256) ? 2 : 1); ++rp_)
            for (int m0 = gw; m0 < MTOK; m0 += 4 * NGW) {
                PHASE_IDS();
                f32x4 sv[4][3]; u32x4 yv[4][2];
                const int colA = lane * 8, colB = 512 + lane * 8;
#pragma unroll
                for (int r = 0; r < 4; ++r) { const int m = min(m0 + r * NGW, MTOK - 1);
                    sv[r][0] = *(const f32x4*)(mss_g + (size_t)m * 4); sv[r][1] = *(const f32x4*)(mss_g + ((size_t)MTOK + m) * 4); sv[r][2] = (f32x4){mss_a[m], mss_a[(size_t)MTOK + m], mss_a[(size_t)2 * MTOK + m], mss_a[(size_t)3 * MTOK + m]};
                    yv[r][0] = *(const u32x4*)(Yg + (size_t)m * DM + colA); yv[r][1] = *(const u32x4*)(Yg + (size_t)m * DM + 512 + (lane & 31) * 8); }
                float nwA[8], nwB[8];
                { const float* p = args.in[12] + layer * 512 + colA;
#pragma unroll
                  for (int i = 0; i < 8; ++i) nwA[i] = p[i];
                  const float* q = args.in[15] + layer * 256 + (lane & 31) * 8;
#pragma unroll
                  for (int i = 0; i < 8; ++i) nwB[i] = q[i]; }
#pragma unroll
                for (int r = 0; r < 4; ++r) { const int m = m0 + r * NGW; if (m < MTOK) {
                    const f32x4 s0 = sv[r][0], s1 = sv[r][1], s2 = sv[r][2];
                    const float r_ssd = rsqrtf((((s0.x + s0.y) + (s0.z + s0.w)) + ((s1.x + s1.y) + (s1.z + s1.w))) * (1.f / 512.f) + EPS);
                    const float r_att = rsqrtf(((s2.x + s2.y) + (s2.z + s2.w)) * (1.f / 256.f) + EPS);
                    float v[8]; unpack8(yv[r][0], v);
#pragma unroll
                    for (int i = 0; i < 8; ++i) v[i] = v[i] * r_ssd * nwA[i];
                    *(u32x4*)(ycat + (size_t)m * DM + colA) = pack8(v);
                    if (lane < 32) { unpack8(yv[r][1], v);
#pragma unroll
                        for (int i = 0; i < 8; ++i) v[i] = v[i] * r_att * nwB[i];
                        *(u32x4*)(ycat + (size_t)m * DM + colB) = pack8(v); } } }
            }
            GRID_SYNC();
#endif
            }
#if PH & 512
            {
                pg8::Gemm g{ycat, Wl + WL_OUT / 2, MTOK, DM, DM}; pg8::StaticOrder S; S.init(MTOK, DM, G, bid);
                EpiResid E{xb, ssq + (size_t)(3 * layer + 2) * MTOK * 4, 1.0f, (LAS float*)(lds + 131072)};
                pg8::gemm_phase<EpiResid, pg8::StaticOrder, true, true>(lds, g, S, E);
            }
            GRID_SYNC();
#endif
        }
    }
#if PH & 1024
    for (int m0 = gw; m0 < MTOK; m0 += 4 * NGW) {
        PHASE_IDS();
        u32x4 xv[4][2]; f32x4 pv4[4];
#pragma unroll
        for (int r = 0; r < 4; ++r) { const int m = min(m0 + r * NGW, MTOK - 1);
            const u32x4* xr = (const u32x4*)(xb + (size_t)m * DM) + lane; xv[r][0] = xr[0]; xv[r][1] = xr[64];
            pv4[r] = *(const f32x4*)(ssq + (size_t)6 * MTOK * 4 + (size_t)m * 4); }
        const f32x4* wv = (const f32x4*)args.in[26];
        f32x4 wq[2][2];
#pragma unroll
        for (int j = 0; j < 2; ++j) { const int c4 = (64 * j + lane) * 2; wq[j][0] = wv[c4]; wq[j][1] = wv[c4 + 1]; }
#pragma unroll
        for (int r = 0; r < 4; ++r) { const int m = m0 + r * NGW; if (m < MTOK) {
            const float rs = rstd4(pv4[r]); f32x4* orow = (f32x4*)(args.out + (size_t)m * DM);
#pragma unroll
            for (int j = 0; j < 2; ++j) {
                float v[8]; unpack8(xv[r][j], v);
                const int c4 = (64 * j + lane) * 2; const f32x4 w0 = wq[j][0], w1 = wq[j][1];
                orow[c4] = (f32x4){v[0] * rs * w0.x, v[1] * rs * w0.y, v[2] * rs * w0.z, v[3] * rs * w0.w};
                orow[c4 + 1] = (f32x4){v[4] * rs * w1.x, v[5] * rs * w1.y, v[6] * rs * w1.z, v[7] * rs * w1.w};
            } } }
    }
#endif
}

extern "C" void kernel_launch(void* const* d_in, const int* in_sizes, int n_in, void* d_out, int out_size, void* d_ws, size_t ws_size, hipStream_t stream) {
    static int grid = 0;
    if (grid == 0) {
        if (n_in != 27 || out_size != MTOK * DM || ws_size < WS_END) { fprintf(stderr, "kernel_launch: unexpected shapes (n_in %d, out %d, ws %zu)\n", n_in, out_size, ws_size); grid = -1; return; }
        int dev = 0, cus = 0, per_cu = 0;
        hipGetDevice(&dev); hipDeviceGetAttribute(&cus, hipDeviceAttributeMultiprocessorCount, dev);
        if (hipFuncSetAttribute((const void*)fwd_megakernel, hipFuncAttributeMaxDynamicSharedMemorySize, LDS_BYTES) != hipSuccess) { fprintf(stderr, "kernel_launch: hipFuncSetAttribute failed\n"); grid = -1; return; }
        if (hipOccupancyMaxActiveBlocksPerMultiprocessor(&per_cu, (const void*)fwd_megakernel, 512, LDS_BYTES) != hipSuccess || per_cu < 1) { fprintf(stderr, "kernel_launch: occupancy query gave %d\n", per_cu); per_cu = 1; }
        (void)hipGetLastError();
        grid = cus * 1;
        fprintf(stderr, "kernel_launch: cus %d per_cu %d grid %d\n", cus, per_cu, grid);
    }
    if (grid < 0) return;
    if (hipMemsetAsync((char*)d_ws + WS_BAR, 0, XCD_BAR_WORDS * 4, stream) != hipSuccess) { fprintf(stderr, "kernel_launch: memset failed\n"); return; }
    Args a{};
    for (int i = 0; i < 27; ++i) a.in[i] = (const float*)d_in[i];
    a.out = (float*)d_out; a.ws = (unsigned char*)d_ws;
    void* kargs[] = {&a};
    hipError_t e = hipLaunchCooperativeKernel((const void*)fwd_megakernel, dim3(grid), dim3(512), kargs, LDS_BYTES, stream);
    if (e != hipSuccess) fprintf(stderr, "kernel_launch: cooperative launch failed: %s (grid %d)\n", hipGetErrorString(e), grid);
}
```

```cpp
#include <hip/hip_runtime.h>
#include <hip/hip_cooperative_groups.h>
#include <cstdio>
#include <cstdint>
namespace cg = cooperative_groups;
namespace pg8 {
#define PG8_LAS __attribute__((address_space(3)))
typedef unsigned short bf16_t;
typedef short bf16x8 __attribute__((ext_vector_type(8)));
typedef float f32x4 __attribute__((ext_vector_type(4)));
typedef unsigned u32x4 __attribute__((ext_vector_type(4)));
constexpr int BM = 256, BK = 64, HALF = 128, HTB = HALF * BK * 2  , STAGE_BYTES = 8 * HTB, NXCD = 8, WGM = 8;

__host__ __device__ __forceinline__ int lds_byte(int r, int c) { const int st = (r >> 4) * 2 + (c >> 5), rr = r & 15, cc = c & 31, ob = rr * 64 + cc * 2; return st * 1024 + (ob ^ (((ob >> 9) & 1) << 5)); }
__host__ __device__ __forceinline__ void stage_rc(int b, int& R, int& C) { const int st = b / 1024, sb = b % 1024, swz = sb ^ (((sb >> 9) & 1) << 5); R = (st >> 1) * 16 + swz / 64; C = (st & 1) * 32 + (swz % 64) / 2; }
__host__ __device__ __forceinline__ int perm32(int rho) { const int n = rho >> 4, i = rho & 15; return 8 * (i >> 2) + 4 * n + (i & 3); }

struct Unit { int pm, pn; };
struct Gemm { const bf16_t* A; const bf16_t* Bt; int M, N, K; };

struct StaticOrder {
    int nM, nN, nwg, G, c;
    __host__ __device__ void init(int M, int N, int G_, int c_) { nM = M / BM; nN = N / BM; nwg = nM * nN; G = G_; c = c_; }
    __host__ __device__ bool next(int i, Unit& u) const {
        const long L = (long)i * G + c; if (L >= nwg) return false;
        int wgid = (int)L; { const int q = nwg / NXCD, r = nwg % NXCD, xcd = wgid % NXCD, off = wgid / NXCD; wgid = (xcd < r ? xcd * (q + 1) : r * (q + 1) + (xcd - r) * q) + off; }
        const int nig = WGM * nN, gid = wgid / nig, fm = gid * WGM, gsz = (nM - fm) < WGM ? (nM - fm) : WGM;
        u.pm = fm + ((wgid % nig) % gsz); u.pn = (wgid % nig) / gsz; return true;
    }
    __device__ __forceinline__ void a_ready(const Unit&) const {}
    __device__ __forceinline__ void done(const Unit&) const {}
};

__device__ __forceinline__ unsigned cvt_pk_bf16(float lo, float hi) { unsigned r; asm volatile("v_cvt_pk_bf16_f32 %0, %1, %2" : "=v"(r) : "v"(lo), "v"(hi)); return r; }
typedef float f32x2 __attribute__((ext_vector_type(2)));
template <class Epi, class Sched, bool ALIGN_EPI = false, bool SP2 = false>
__device__ __forceinline__ void gemm_phase(PG8_LAS unsigned char* lds, const Gemm g, const Sched& S, const Epi& E) {
    int tid_; asm volatile("v_mov_b32 %0, %1" : "=v"(tid_) : "v"((int)threadIdx.x));
    const int tid = tid_, wid = __builtin_amdgcn_readfirstlane(tid >> 6), lane = tid & 63, wr = wid >> 2, wc = wid & 3, fr = lane & 15, fq = lane >> 4;
    const int K = g.K, nt = K / BK;
    unsigned voffA[2], voffB[2];
#pragma unroll
    for (int i = 0; i < 2; ++i) { int R, C; stage_rc(tid * 16 + i * 8192, R, C); const int Rb = Epi::PERM ? ((R & ~31) + perm32(R & 31)) : R;
        voffA[i] = (unsigned)(R * K + C) * 2u; voffB[i] = (unsigned)(Rb * K + C) * 2u; }
    const size_t kstep = (size_t)(BK * 2);
    const size_t hstep = (size_t)HALF * K * 2;
    const size_t tstep = 2 * hstep;
    const unsigned ldsw = (unsigned)wid * 1024u;
    const int aoff = lds_byte(wr * 64 + fr, fq * 8), boff = lds_byte(wc * 32 + fr, fq * 8);
#define PG8_SA(b, h) (((b) * 2 + (h)) * HTB)
#define PG8_SB(b, h) ((4 + (b) * 2 + (h)) * HTB)
#define PG8_STAGE(bufoff, gbase, voff) do { _Pragma("unroll") for (int _i = 0; _i < 2; ++_i) \
        __builtin_amdgcn_global_load_lds((const unsigned*)((const char*)(gbase) + (voff)[_i]), (PG8_LAS unsigned*)(lds + (bufoff) + ldsw + _i * 8192), 16, 0, 0); } while (0)
#define PG8_LDA(dst, b, h) do { _Pragma("unroll") for (int m = 0; m < 4; ++m) _Pragma("unroll") for (int k = 0; k < 2; ++k) dst[m][k] = *(const PG8_LAS bf16x8*)(lds + PG8_SA(b, h) + aoff + m * 2048 + k * 1024); } while (0)
#define PG8_LDB(dst, b, h) do { _Pragma("unroll") for (int n = 0; n < 2; ++n) _Pragma("unroll") for (int k = 0; k < 2; ++k) dst[n][k] = *(const PG8_LAS bf16x8*)(lds + PG8_SB(b, h) + boff + n * 2048 + k * 1024); } while (0)
#define PG8_MMA(ai, bj, At, Bt) do { __builtin_amdgcn_s_setprio(1); _Pragma("unroll") for (int m = 0; m < 4; ++m) _Pragma("unroll") for (int n = 0; n < 2; ++n) _Pragma("unroll") for (int k = 0; k < 2; ++k) \
        acc[ai][bj][m][n] = __builtin_amdgcn_mfma_f32_16x16x32_bf16(Bt[n][k], At[m][k], acc[ai][bj][m][n], 0, 0, 0); __builtin_amdgcn_s_setprio(0); } while (0)
#define PG8_WAIT_V(n) asm volatile("s_waitcnt vmcnt(" #n ")" ::: "memory")
#define PG8_WAIT_L(n) asm volatile("s_waitcnt lgkmcnt(" #n ")" ::: "memory")
#define PG8_BAR __builtin_amdgcn_s_barrier()
#define PG8_SCHED __builtin_amdgcn_sched_barrier(0)
    Unit cur, nxt; int ui = 0;
    if (!S.next(0, cur)) return;
    f32x4 acc[2][2][4][2];
#pragma unroll
    for (int a = 0; a < 2; ++a)
#pragma unroll
        for (int b = 0; b < 2; ++b)
#pragma unroll
            for (int m = 0; m < 4; ++m)
#pragma unroll
                for (int n = 0; n < 2; ++n) acc[a][b][m][n] = (f32x4){0.f, 0.f, 0.f, 0.f};
    bf16x8 At[4][2], B0[2][2], B1[2][2];
    const char* cA = (const char*)g.A + (size_t)cur.pm * tstep; const char* cB = (const char*)g.Bt + (size_t)cur.pn * tstep;
    S.a_ready(cur);
    if constexpr (SP2) {
        PG8_STAGE(PG8_SB(0, 0), cB, voffB); PG8_STAGE(PG8_SB(0, 1), cB + hstep, voffB); PG8_STAGE(PG8_SA(0, 0), cA, voffA); PG8_STAGE(PG8_SA(0, 1), cA + hstep, voffA);
        if (wr == 1) PG8_BAR;
        PG8_WAIT_V(2); PG8_BAR;
        PG8_STAGE(PG8_SB(1, 0), cB + kstep, voffB); PG8_STAGE(PG8_SA(1, 0), cA + kstep, voffA); PG8_STAGE(PG8_SB(1, 1), cB + hstep + kstep, voffB);
        PG8_WAIT_V(6); PG8_BAR;
    } else {
        PG8_STAGE(PG8_SB(0, 0), cB, voffB); PG8_STAGE(PG8_SA(0, 0), cA, voffA); PG8_STAGE(PG8_SB(0, 1), cB + hstep, voffB); PG8_STAGE(PG8_SA(0, 1), cA + hstep, voffA);
        if (wr == 1) PG8_BAR;
        PG8_WAIT_V(4); PG8_BAR;
        PG8_STAGE(PG8_SB(1, 0), cB + kstep, voffB); PG8_STAGE(PG8_SA(1, 0), cA + kstep, voffA); PG8_STAGE(PG8_SB(1, 1), cB + hstep + kstep, voffB);
        PG8_WAIT_V(6); PG8_BAR;
    }
    for (;;) {
        const bool has_next = S.next(ui + 1, nxt);
        const char* nA = has_next ? (const char*)g.A + (size_t)nxt.pm * tstep : cA; const char* nB = has_next ? (const char*)g.Bt + (size_t)nxt.pn * tstep : cB;
        for (int t = 0; t < nt; t += 2) {
            const bool last = (t == nt - 2);
            const char* a1 = cA + (size_t)(t + 1) * kstep;
            const char* a2 = last ? nA : cA + (size_t)(t + 2) * kstep; const char* b2 = last ? nB : cB + (size_t)(t + 2) * kstep;
            const char* a3 = a2 + kstep; const char* b3 = b2 + kstep;
            if (last && has_next) S.a_ready(nxt);
            if constexpr (SP2) {
            PG8_LDB(B0, 0, 0); PG8_LDB(B1, 0, 1); PG8_SCHED; PG8_LDA(At, 0, 0); PG8_STAGE(PG8_SA(1, 1), a1 + hstep, voffA);
            PG8_WAIT_V(8); PG8_WAIT_L(0); PG8_BAR; PG8_MMA(0, 0, At, B0); PG8_MMA(0, 1, At, B1); PG8_BAR; PG8_SCHED;
            PG8_LDA(At, 0, 1); PG8_STAGE(PG8_SB(0, 0), b2, voffB); PG8_STAGE(PG8_SB(0, 1), b2 + hstep, voffB); PG8_STAGE(PG8_SA(0, 0), a2, voffA);
            PG8_WAIT_V(8); PG8_WAIT_L(0); PG8_BAR; PG8_MMA(1, 0, At, B0); PG8_MMA(1, 1, At, B1); PG8_BAR; PG8_SCHED;
            PG8_LDB(B0, 1, 0); PG8_LDB(B1, 1, 1); PG8_SCHED; PG8_LDA(At, 1, 0); PG8_STAGE(PG8_SA(0, 1), a2 + hstep, voffA);
            PG8_WAIT_V(8); PG8_WAIT_L(0); PG8_BAR; PG8_MMA(0, 0, At, B0); PG8_MMA(0, 1, At, B1); PG8_BAR; PG8_SCHED;
            PG8_LDA(At, 1, 1); PG8_STAGE(PG8_SB(1, 0), b3, voffB); PG8_STAGE(PG8_SB(1, 1), b3 + hstep, voffB); PG8_STAGE(PG8_SA(1, 0), a3, voffA);
            PG8_WAIT_V(8); PG8_WAIT_L(0); PG8_BAR; PG8_MMA(1, 0, At, B0); PG8_MMA(1, 1, At, B1); PG8_BAR; PG8_SCHED;
            } else {
            PG8_LDB(B0, 0, 0); PG8_SCHED; PG8_LDA(At, 0, 0); PG8_STAGE(PG8_SA(1, 1), a1 + hstep, voffA);
            PG8_WAIT_L(8); PG8_BAR; PG8_WAIT_L(0); PG8_MMA(0, 0, At, B0); PG8_BAR; PG8_SCHED;
            PG8_LDB(B1, 0, 1); PG8_STAGE(PG8_SB(0, 0), b2, voffB);
            PG8_BAR; PG8_WAIT_L(0); PG8_MMA(0, 1, At, B1); PG8_BAR;
            PG8_LDA(At, 0, 1); PG8_STAGE(PG8_SA(0, 0), a2, voffA);
            PG8_BAR; PG8_WAIT_L(0); PG8_MMA(1, 0, At, B0); PG8_BAR; PG8_SCHED;
            PG8_STAGE(PG8_SB(0, 1), b2 + hstep, voffB);
            PG8_WAIT_V(6); PG8_BAR; PG8_MMA(1, 1, At, B1); PG8_BAR;
            PG8_LDB(B0, 1, 0); PG8_SCHED; PG8_LDA(At, 1, 0); PG8_STAGE(PG8_SA(0, 1), a2 + hstep, voffA);
            PG8_WAIT_L(8); PG8_BAR; PG8_WAIT_L(0); PG8_MMA(0, 0, At, B0); PG8_BAR; PG8_SCHED;
            PG8_LDB(B1, 1, 1); PG8_STAGE(PG8_SB(1, 0), b3, voffB);
            PG8_BAR; PG8_WAIT_L(0); PG8_MMA(0, 1, At, B1); PG8_BAR;
            PG8_LDA(At, 1, 1); PG8_STAGE(PG8_SA(1, 0), a3, voffA);
            PG8_BAR; PG8_WAIT_L(0); PG8_MMA(1, 0, At, B0); PG8_BAR; PG8_SCHED;
            PG8_STAGE(PG8_SB(1, 1), b3 + hstep, voffB);
            PG8_WAIT_V(6); PG8_BAR; PG8_MMA(1, 1, At, B1); PG8_BAR;
            }
        }
        if constexpr (ALIGN_EPI) { if (wr == 0) PG8_BAR; }
        if constexpr (!Epi::AFTER_DRAIN) { E(acc, cur, wr, wc, fr, fq); S.done(cur); }
        if (!has_next) break;
#pragma unroll
        for (int a = 0; a < 2; ++a)
#pragma unroll
            for (int b = 0; b < 2; ++b)
#pragma unroll
                for (int m = 0; m < 4; ++m)
#pragma unroll
                    for (int n = 0; n < 2; ++n) acc[a][b][m][n] = (f32x4){0.f, 0.f, 0.f, 0.f};
        cur = nxt; cA = nA; cB = nB; ++ui;
        if constexpr (ALIGN_EPI) { if (wr == 1) PG8_BAR; }
    }
    PG8_WAIT_V(0);
    if constexpr (!ALIGN_EPI) { if (wr == 0) PG8_BAR; }
    PG8_BAR;
    if constexpr (Epi::AFTER_DRAIN) { E.fused(acc, cur, wr, wc, fr, fq, lds, wid, lane); S.done(cur); }
#undef PG8_SA
#undef PG8_SB
#undef PG8_STAGE
#undef PG8_LDA
#undef PG8_LDB
#undef PG8_MMA
#undef PG8_WAIT_V
#undef PG8_WAIT_L
#undef PG8_BAR
#undef PG8_SCHED
}
}

#define LAS __attribute__((address_space(3)))
#define DI __device__ __forceinline__
typedef unsigned short bf16;
typedef short bf16x8 __attribute__((ext_vector_type(8)));
typedef float f32x4 __attribute__((ext_vector_type(4)));
typedef unsigned u32x4 __attribute__((ext_vector_type(4)));
typedef unsigned u32x2 __attribute__((ext_vector_type(2)));

constexpr int BATCH = 8, SEQ = 4096, DM = 1024, MTOK = BATCH * SEQ, DFF = 2816, DEPTH = 2;
constexpr int NGU = 2 * DFF;
constexpr int NPROJ = 2816;
constexpr int DINP = 2568;
constexpr int PC_Z = 0, PC_XBC = 512, PC_Q = 1536, PC_K = 1792, PC_V = 1920, PC_U = 2048, PC_GV = 2304, PC_DT = 2560;
constexpr int NCH = 32;
constexpr float EPS = 1e-6f;
constexpr size_t MiB = 1u << 20;
constexpr size_t WS_BAR = 65536, WS_CD = 0, WS_SSQ = 89 * MiB, WS_MSSQ = 3 * MiB, WS_DTRAW = 5 * MiB, WS_SGUW = 6 * MiB, WS_W = 8 * MiB;
constexpr size_t WL_GU1 = 0, WL_D1 = 11 * MiB, WL_IN = WL_D1 + 5632 * 1024, WL_OUT = WL_IN + 5632 * 1024, WL_GU2 = WL_OUT + 2 * MiB, WL_D2 = WL_GU2 + 11 * MiB, WL_SIZE = WL_D2 + 5632 * 1024;
constexpr size_t WS_XB = 96 * MiB, WS_ST = 96 * MiB, WS_ACT = 160 * MiB, WS_YG = 160 * MiB, WS_YCAT = 224 * MiB, WS_PV = 288 * MiB, WS_PROJ = 336 * MiB, WS_END = 512 * MiB;
static_assert(WS_W + 2 * WL_SIZE <= WS_XB, "weights fit");
constexpr int LDS_BYTES = 147456;
#ifndef PH
#define PH 2047
#endif

__device__ const unsigned char T5_BUCKET[128] = {0,1,2,3,4,5,6,7,8,9,10,11,12,13,14,15,16,16,16,17,17,18,18,18,19,19,19,20,20,20,20,21,21,21,21,22,22,22,22,22,23,23,23,23,23,23,24,24,24,24,24,24,25,25,25,25,25,25,25,26,26,26,26,26,26,26,26,27,27,27,27,27,27,27,27,27,27,28,28,28,28,28,28,28,28,28,28,29,29,29,29,29,29,29,29,29,29,29,29,30,30,30,30,30,30,30,30,30,30,30,30,30,30,31,31,31,31,31,31,31,31,31,31,31,31,31,31,31};

DI float bf2f(unsigned short b) { return __uint_as_float((unsigned)b << 16); }
typedef float f32x2_t __attribute__((ext_vector_type(2)));
typedef __bf16 bf16x2_t __attribute__((ext_vector_type(2)));
DI unsigned pk2(float lo, float hi) { const f32x2_t v = {lo, hi}; const bf16x2_t b = __builtin_convertvector(v, bf16x2_t); return __builtin_bit_cast(unsigned, b); }
DI unsigned short f2bf(float f) { return (unsigned short)(pk2(f, 0.f) & 0xffffu); }
DI void unpack8(u32x4 r, float (&v)[8]) {
    v[0] = __uint_as_float(r.x << 16); v[1] = __uint_as_float(r.x & 0xffff0000u); v[2] = __uint_as_float(r.y << 16); v[3] = __uint_as_float(r.y & 0xffff0000u);
    v[4] = __uint_as_float(r.z << 16); v[5] = __uint_as_float(r.z & 0xffff0000u); v[6] = __uint_as_float(r.w << 16); v[7] = __uint_as_float(r.w & 0xffff0000u);
}
DI u32x4 pack8(const float (&v)[8]) { u32x4 r; r.x = pk2(v[0], v[1]); r.y = pk2(v[2], v[3]); r.z = pk2(v[4], v[5]); r.w = pk2(v[6], v[7]); return r; }
DI float fast_sigmoid(float x) { return __builtin_amdgcn_rcpf(1.f + __builtin_amdgcn_exp2f(-1.4426950409f * x)); }
DI float silu_f(float x) { return x * fast_sigmoid(x); }
DI float gelu_f(float x) { const float u = 1.5957691216f * (x + 0.044715f * x * x * x); return x * fast_sigmoid(u); }
DI int opaque_tid() { int t; asm volatile("v_mov_b32 %0, %1" : "=v"(t) : "v"((int)threadIdx.x)); return t; }
#define PHASE_IDS() const int tid = opaque_tid(), lane = tid & 63, r16 = lane & 15, q4 = lane >> 4; (void)r16; (void)q4; (void)tid
DI bool lane0_() { return (opaque_tid() & 63) == 0; }
DI float wave_sum(float v) {
#pragma unroll
    for (int o = 1; o < 64; o <<= 1) v += __shfl_xor(v, o);
    return v;
}
DI float sum16(float v) { v += __shfl_xor(v, 1); v += __shfl_xor(v, 2); v += __shfl_xor(v, 4); v += __shfl_xor(v, 8); return v; }
DI float max16(float v) { v = fmaxf(v, __shfl_xor(v, 1)); v = fmaxf(v, __shfl_xor(v, 2)); v = fmaxf(v, __shfl_xor(v, 4)); v = fmaxf(v, __shfl_xor(v, 8)); return v; }
DI f32x4 mfma16(bf16x8 a, bf16x8 b, f32x4 c) { return __builtin_amdgcn_mfma_f32_16x16x32_bf16(a, b, c, 0, 0, 0); }
DI bf16x8 lds_frag(const LAS bf16* base, int row, int stride, int k) { return *(const LAS bf16x8*)(base + row * stride + k); }
DI float rstd4(f32x4 p) { return rsqrtf(((p.x + p.y) + (p.z + p.w)) * (1.f / DM) + EPS); }
DI float row_rstd(const float* ssq, unsigned row) { return rstd4(*(const f32x4*)(ssq + row * 4u)); }

using pg8::Unit;
DI void cached_rs8(float (&rs8)[8], const float* ssq, LAS float* rtab, const Unit& u, int wr, int wc, int fr, int fq) {
    LAS float* tab = rtab + (wr * 4 + wc) * 132;
    LAS int* tag = (LAS int*)(tab + 128);
    const int ln = fq * 16 + fr;
    if (tag[0] != u.pm) {
#pragma unroll
        for (int hh = 0; hh < 2; ++hh) { const int k = ln + 64 * hh; const unsigned row = u.pm * 256 + (k >> 6) * 128 + wr * 64 + ((k >> 4) & 3) * 16 + (k & 15);
            tab[k] = rstd4(*(const f32x4*)(ssq + row * 4u)); }
        if (ln == 0) tag[0] = u.pm;
    }
#pragma unroll
    for (int k = 0; k < 8; ++k) rs8[k] = tab[(k >> 2) * 64 + (k & 3) * 16 + fr];
}

struct EpiSwiglu {
    static constexpr bool PERM = true, AFTER_DRAIN = false;
    bf16* O; const float* ssq; LAS float* rtab;
    DI void operator()(const f32x4 (&acc)[2][2][4][2], const Unit& u, int wr, int wc, int fr, int fq) const {
        const unsigned row0 = u.pm * 256 + wr * 64 + fr; const unsigned col0 = u.pn * 128 + wc * 32 + 8 * fq;
        float rs8[8]; cached_rs8(rs8, ssq, rtab, u, wr, wc, fr, fq);
        unsigned row = row0;
#pragma unroll
        for (int ai = 0; ai < 2; ++ai) {
#pragma unroll
            for (int m = 0; m < 4; ++m) {
                const float rs = rs8[ai * 4 + m];
                float h[8];
#pragma unroll
                for (int n = 0; n < 2; ++n)
#pragma unroll
                    for (int i = 0; i < 4; ++i) { const float g = acc[ai][0][m][n][i] * rs, uu = acc[ai][1][m][n][i] * rs; h[n * 4 + i] = g * uu * fast_sigmoid(g); }
                *(u32x4*)(O + (row * (unsigned)DFF + col0)) = pack8(h);
                asm volatile("" : "+v"(row));
                row += 16;
            }
            row += 64;
        }
    }
};
struct EpiResid {
    static constexpr bool PERM = true, AFTER_DRAIN = false;
    bf16* xb; float* ssq; float alpha; LAS float* red;
    DI void operator()(const f32x4 (&acc)[2][2][4][2], const Unit& u, int wr, int wc, int fr, int fq) const {
        unsigned row = u.pm * 256 + wr * 64 + fr; const unsigned col0 = u.pn * 256 + wc * 32 + 8 * fq;
        u32x4 bv[2][4][2];
#pragma unroll
        for (int ai = 0; ai < 2; ++ai)
#pragma unroll
            for (int m = 0; m < 4; ++m)
#pragma unroll
                for (int bj = 0; bj < 2; ++bj) bv[ai][m][bj] = *(const u32x4*)(xb + ((row + 128 * ai + 16 * m) * (unsigned)DM + col0 + bj * 128));
#pragma unroll
        for (int ai = 0; ai < 2; ++ai) {
#pragma unroll
            for (int m = 0; m < 4; ++m) {
                float ss = 0.f; const unsigned off0 = row * (unsigned)DM + col0;
#pragma unroll
                for (int bj = 0; bj < 2; ++bj) {
                    float o[8]; unpack8(bv[ai][m][bj], o);
#pragma unroll
                    for (int n = 0; n < 2; ++n)
#pragma unroll
                        for (int i = 0; i < 4; ++i) { o[n * 4 + i] += acc[ai][bj][m][n][i] * alpha; ss += o[n * 4 + i] * o[n * 4 + i]; }
                    *(u32x4*)(xb + (off0 + bj * 128)) = pack8(o);
                }
                ss += __shfl_xor(ss, 16); ss += __shfl_xor(ss, 32);
                if (fq == 0) red[(ai * 128 + wr * 64 + m * 16 + fr) * 4 + wc] = ss;
                asm volatile("" : "+v"(row));
                row += 16;
            }
            asm volatile("" ::: "memory");
            row += 64;
        }
        asm volatile("s_waitcnt lgkmcnt(0)" ::: "memory"); __builtin_amdgcn_s_barrier(); asm volatile("" ::: "memory");
        const int t = (wr * 4 + wc) * 64 + fq * 16 + fr;
        if (t < 256) { const f32x4 p = *(const LAS f32x4*)(red + t * 4); ssq[(u.pm * 256 + t) * 4u + u.pn] = (p.x + p.y) + (p.z + p.w); }
    }
};
struct EpiProj {
    static constexpr bool PERM = true, AFTER_DRAIN = false;
    bf16* O; const float* ssq; LAS float* rtab;
    DI void operator()(const f32x4 (&acc)[2][2][4][2], const Unit& u, int wr, int wc, int fr, int fq) const {
        const unsigned row0 = u.pm * 256 + wr * 64 + fr; const unsigned col0 = u.pn * 256 + wc * 32 + 8 * fq;
        float rs8[8]; cached_rs8(rs8, ssq, rtab, u, wr, wc, fr, fq);
        unsigned row = row0;
#pragma unroll
        for (int ai = 0; ai < 2; ++ai) {
#pragma unroll
            for (int m = 0; m < 4; ++m) {
                const float rs = rs8[ai * 4 + m];
#pragma unroll
                for (int bj = 0; bj < 2; ++bj) {
                    float h[8];
#pragma unroll
                    for (int n = 0; n < 2; ++n)
#pragma unroll
                        for (int i = 0; i < 4; ++i) h[n * 4 + i] = acc[ai][bj][m][n][i] * rs;
                    *(u32x4*)(O + (row * (unsigned)NPROJ + col0 + bj * 128)) = pack8(h);
                }
                asm volatile("" : "+v"(row));
                row += 16;
            }
            row += 64;
        }
    }
};

DI const float* src_col(int kind, const float* g, const float* u, int n) {
    if (kind == 0) return g + n;
    if (kind == 1) { const int t = n >> 8, w = n & 255; return (w < 128) ? g + 128 * t + w : u + 128 * t + (w - 128); }
    if (n < 1536) return g + n;
    if (n < 2560) return g + n + 8;
    if (n < 2568) return g + 1536 + (n - 2560);
    return nullptr;
}
DI void transpose_item(int kind, const float* g, const float* u, int ldn, int K, int Np, const float* kscale, bf16* WT, LAS float* scr, int item, int lane) {
    const int nblk = Np / 32, kb = item / nblk, nb = item % nblk, k0 = 64 * kb, n0 = 32 * nb;
    const float* colp = src_col(kind, g, u, n0 + (lane & 31));
    float v[32];
    if (colp) {
        const float* p = colp + (size_t)(k0 + (lane >> 5)) * ldn;
#pragma unroll
        for (int i = 0; i < 32; ++i) v[i] = p[(size_t)(2 * i) * ldn];
    } else {
#pragma unroll
        for (int i = 0; i < 32; ++i) v[i] = 0.f;
    }
#pragma unroll
    for (int i = 0; i < 32; ++i) scr[(2 * i + (lane >> 5)) * 33 + (lane & 31)] = v[i];
    asm volatile("s_waitcnt lgkmcnt(0)" ::: "memory");
    const int c = lane & 7;
    float ks[8];
    if (kscale) { const f32x4 a = *(const f32x4*)(kscale + k0 + 8 * c), b2 = *(const f32x4*)(kscale + k0 + 8 * c + 4); ks[0] = a.x; ks[1] = a.y; ks[2] = a.z; ks[3] = a.w; ks[4] = b2.x; ks[5] = b2.y; ks[6] = b2.z; ks[7] = b2.w; }
    else {
#pragma unroll
        for (int i = 0; i < 8; ++i) ks[i] = 1.f;
    }
#pragma unroll
    for (int j = 0; j < 4; ++j) { const int n = (lane >> 3) + 8 * j; const LAS float* sp = scr + (8 * c) * 33 + n;
        u32x4 o; o.x = pk2(sp[0 * 33] * ks[0], sp[1 * 33] * ks[1]); o.y = pk2(sp[2 * 33] * ks[2], sp[3 * 33] * ks[3]); o.z = pk2(sp[4 * 33] * ks[4], sp[5 * 33] * ks[5]); o.w = pk2(sp[6 * 33] * ks[6], sp[7 * 33] * ks[7]);
        *(u32x4*)(WT + (size_t)(n0 + n) * K + k0 + 8 * c) = o; }
    asm volatile("s_waitcnt lgkmcnt(0)" ::: "memory");
}

DI void conv_load(u32x4 (&Rraw)[19], f32x4 (&Rw)[8], f32x4 (&Rb)[2], const bf16* __restrict__ proj, const float* __restrict__ cw, const float* __restrict__ cb, int pcol, size_t grow0, int c, int l0) {
    const int ch = pcol - PC_XBC;
    const bf16* p = proj + grow0 * NPROJ + pcol;
#pragma unroll
    for (int r = 0; r < 19; ++r) { const int l = l0 - 3 + r; Rraw[r] = (c == 0 && l < 0) ? (u32x4){0u, 0u, 0u, 0u} : *(const u32x4*)(p + (long)l * NPROJ); }
#pragma unroll
    for (int j = 0; j < 4; ++j) { Rw[2 * j] = *(const f32x4*)(cw + j * 1024 + ch); Rw[2 * j + 1] = *(const f32x4*)(cw + j * 1024 + ch + 4); }
    Rb[0] = *(const f32x4*)(cb + ch); Rb[1] = *(const f32x4*)(cb + ch + 4);
}
template <class F>
DI void conv_apply(const u32x4 (&Rraw)[19], const f32x4 (&Rw)[8], const f32x4 (&Rb)[2], int l0, F f) {
    float w[4][8], bias[8];
#pragma unroll
    for (int j = 0; j < 4; ++j)
#pragma unroll
        for (int i = 0; i < 4; ++i) { w[j][i] = Rw[2 * j][i]; w[j][4 + i] = Rw[2 * j + 1][i]; }
#pragma unroll
    for (int i = 0; i < 4; ++i) { bias[i] = Rb[0][i]; bias[4 + i] = Rb[1][i]; }
    float x0[8], x1[8], x2[8], x3[8];
    unpack8(Rraw[0], x0); unpack8(Rraw[1], x1); unpack8(Rraw[2], x2);
#pragma unroll
    for (int r = 0; r < 16; ++r) {
        unpack8(Rraw[r + 3], x3);
        float o[8];
#pragma unroll
        for (int i = 0; i < 8; ++i) { const float y = bias[i] + w[0][i] * x0[i] + w[1][i] * x1[i] + w[2][i] * x2[i] + w[3][i] * x3[i]; o[i] = silu_f(y); }
        f(l0 + r, o);
#pragma unroll
        for (int i = 0; i < 8; ++i) { x0[i] = x1[i]; x1[i] = x2[i]; x2[i] = x3[i]; }
        __builtin_amdgcn_sched_barrier(0);
    }
}

DI void ssd_dt_acs_wave(float x0, float x1, float negA, LAS float* s_dt, LAS float* s_acs, int lane) {
    const float d0 = (x0 > 20.f) ? x0 : log1pf(__expf(x0)), d1 = (x1 > 20.f) ? x1 : log1pf(__expf(x1));
    const float a0 = d0 * negA, a1 = d1 * negA;
    float sc = a0 + a1;
#pragma unroll
    for (int o = 1; o < 64; o <<= 1) { const float t = __shfl_up(sc, o); if (lane >= o) sc += t; }
    s_dt[2 * lane] = d0; s_dt[2 * lane + 1] = d1; s_acs[2 * lane] = sc - a1; s_acs[2 * lane + 1] = sc;
}

#define XB_TMO      128
#define XB_XCNT(j)  (256  + 64 * (j))
#define XB_XSUB(j)  (1280 + 64 * (j))
#define XB_XGEN(j)  (2304 + 64 * (j))
#define XB_TOP      3328
#define XB_TOPGEN   3392
#define XCD_BAR_WORDS 3456
#define XB_SPIN_CAP (1u << 18)

__device__ __forceinline__ unsigned xb_ld(unsigned* p)              { return __hip_atomic_load(p, __ATOMIC_RELAXED, __HIP_MEMORY_SCOPE_AGENT); }
__device__ __forceinline__ unsigned xb_add(unsigned* p, unsigned v) { return __hip_atomic_fetch_add(p, v, __ATOMIC_RELAXED, __HIP_MEMORY_SCOPE_AGENT); }
__device__ __forceinline__ unsigned xb_xcc_id() { return (unsigned)__builtin_amdgcn_s_getreg((3 << 11) | 20) & 0xFu; }
#define XB_SPIN(cond, bar) do { unsigned _sp = 0; while (cond) { __builtin_amdgcn_s_sleep(1); \
    if ((++_sp & 255u) == 0u) { if (xb_ld(&(bar)[XB_TMO])) break; if (_sp > XB_SPIN_CAP) { atomicAdd(&(bar)[XB_TMO], 1u); break; } } } } while (0)

struct XcdBarrier {
    unsigned* bar; unsigned x;
    volatile LAS unsigned* st;
};

__device__ __forceinline__ XcdBarrier xcd_barrier_post(unsigned* bar, volatile LAS unsigned* st) {
    XcdBarrier b; b.bar = bar; b.x = xb_xcc_id(); b.st = st;
    if (threadIdx.x == 0) (void)xb_add(&bar[XB_XCNT(b.x)], 1u);
    return b;
}
__device__ __forceinline__ void xcd_barrier_complete(unsigned* bar, unsigned x, unsigned& nloc, unsigned& nx) {
    const unsigned G = gridDim.x * gridDim.y * gridDim.z;
    unsigned sum, cnt, mine, sp = 0u;
    for (;;) {
        sum = 0u; cnt = 0u; mine = 0u;
#pragma unroll
        for (unsigned j = 0; j < 16; ++j) { const unsigned c = xb_ld(&bar[XB_XCNT(j)]); sum += c; cnt += (c > 0u) ? 1u : 0u; mine = (j == x) ? c : mine; }
        if (sum == G) break;
        __builtin_amdgcn_s_sleep(1);
        if ((++sp & 255u) == 0u) { if (xb_ld(&bar[XB_TMO])) break; if (sp > XB_SPIN_CAP) { atomicAdd(&bar[XB_TMO], 1u); break; } }
    }
    nloc = mine > 0u ? mine : 1u; nx = cnt > 0u ? cnt : 1u;
}

__device__ __forceinline__ void xcd_barrier(const XcdBarrier& b) {
    asm volatile("s_waitcnt vmcnt(0)" ::: "memory");
    __syncthreads();
    if (threadIdx.x == 0) {
        unsigned* bar = b.bar;
        __builtin_amdgcn_s_waitcnt(0);
        unsigned nloc = b.st[0], nx = b.st[1];
        if (nloc == 0u) { xcd_barrier_complete(bar, b.x, nloc, nx); b.st[0] = nloc; b.st[1] = nx; }
        const unsigned old = xb_add(&bar[XB_XSUB(b.x)], 1u);
        const unsigned gen = old / nloc;
        if (old + 1u == (gen + 1u) * nloc) {
            __builtin_amdgcn_fence(__ATOMIC_RELEASE, "agent");
            asm volatile("s_waitcnt vmcnt(0)" ::: "memory");
            const unsigned og = xb_add(&bar[XB_TOP], 1u);
            const unsigned tg = og / nx;
            if (og + 1u == (tg + 1u) * nx) xb_add(&bar[XB_TOPGEN], 1u);
            else XB_SPIN(xb_ld(&bar[XB_TOPGEN]) == tg, bar);
            __builtin_amdgcn_fence(__ATOMIC_ACQUIRE, "agent");
            xb_add(&bar[XB_XGEN(b.x)], 1u);
            asm volatile("s_waitcnt vmcnt(0)" ::: "memory");
        } else {
            XB_SPIN(xb_ld(&bar[XB_XGEN(b.x)]) == gen, bar);
            __builtin_amdgcn_fence(__ATOMIC_ACQUIRE, "agent");
            asm volatile("s_waitcnt vmcnt(0)" ::: "memory");
        }
    }
    __syncthreads();
}

struct Args { const float* in[27]; float* out; unsigned char* ws; };

__global__ void __launch_bounds__(512, 2) fwd_megakernel(Args args) {
    extern __shared__ __attribute__((aligned(16))) unsigned char lds_raw[];
    LAS unsigned char* lds = (LAS unsigned char*)lds_raw;
    cg::grid_group grid = cg::this_grid();
    if (args.ws == nullptr) grid.sync();
    volatile LAS unsigned* bst = (volatile LAS unsigned*)(lds + 147440);
    if (threadIdx.x < 4) bst[threadIdx.x] = 0u;
    __syncthreads();
    (void)xcd_barrier_post((unsigned*)(args.ws + WS_BAR), bst);
#define GRID_SYNC() do { XcdBarrier b_; b_.bar = (unsigned*)(args.ws + WS_BAR); b_.x = xb_xcc_id(); b_.st = (volatile LAS unsigned*)(lds + 147440); xcd_barrier(b_); } while (0)
    const int wave = __builtin_amdgcn_readfirstlane((int)threadIdx.x >> 6);
    const int G = gridDim.x, bid = blockIdx.x;
    const int gw = bid * 8 + wave, NGW = G * 8;
    unsigned char* ws = args.ws;
    float* ssq = (float*)(ws + WS_SSQ);     float* mss_g = (float*)(ws + WS_MSSQ);   float* mss_a = mss_g + (size_t)2 * MTOK * 4;   float* dtraw = (float*)(ws + WS_DTRAW); float* CD = (float*)(ws + WS_CD);
    bf16* sguW = (bf16*)(ws + WS_SGUW);
    bf16* xb = (bf16*)(ws + WS_XB); float* ST = args.out;     bf16* actb = (bf16*)(ws + WS_ACT); bf16* Yg = (bf16*)(ws + WS_YG); bf16* ycat = (bf16*)(ws + WS_YCAT);
    bf16* PV = (bf16*)(ws + WS_PV); bf16* proj = (bf16*)(ws + WS_PROJ);

#if PH & 1
#ifndef PROREP
#define PROREP 1
#endif
#ifndef SYNCREP
#define SYNCREP 0
#endif
    for (int rep_ = 0; rep_ < SYNCREP; ++rep_) GRID_SYNC();
    for (int rep_ = 0; rep_ < PROREP; ++rep_) {
        PHASE_IDS();
        LAS float* scr = (LAS float*)(lds + wave * 16384);
        for (int mi = 0; mi < 12; ++mi) {
            const int l = mi / 6, t = mi % 6;
            const float* g; const float* u = nullptr; const float* ks = nullptr; int kind = 0, ldn, K, Np; bf16* WT = (bf16*)(ws + WS_W + (size_t)l * WL_SIZE);
            if (t == 0)      { g = args.in[2] + (size_t)l * DM * DFF; u = args.in[3] + (size_t)l * DM * DFF; ks = args.in[1] + l * DM; kind = 1; ldn = DFF; K = DM; Np = NGU; WT += WL_GU1 / 2; }
            else if (t == 1) { g = args.in[4] + (size_t)l * DFF * DM; ldn = DM; K = DFF; Np = DM; WT += WL_D1 / 2; }
            else if (t == 2) { g = args.in[6] + (size_t)l * DM * DINP; ks = args.in[5] + l * DM; kind = 2; ldn = DINP; K = DM; Np = NPROJ; WT += WL_IN / 2; }
            else if (t == 3) { g = args.in[21] + (size_t)l * DM * DM; ldn = DM; K = DM; Np = DM; WT += WL_OUT / 2; }
            else if (t == 4) { g = args.in[23] + (size_t)l * DM * DFF; u = args.in[24] + (size_t)l * DM * DFF; ks = args.in[22] + l * DM; kind = 1; ldn = DFF; K = DM; Np = NGU; WT += WL_GU2 / 2; }
            else             { g = args.in[25] + (size_t)l * DFF * DM; ldn = DM; K = DFF; Np = DM; WT += WL_D2 / 2; }
            const int nitems = (K / 64) * (Np / 32);
            for (int it = gw; it < nitems; it += NGW) transpose_item(kind, g, u, ldn, K, Np, ks, WT, scr, it, lane);
        }
        for (int i = bid * 512 + tid; i < DEPTH * 4 * 128 * 128; i += G * 512) { const int t = (i >> 7) & 127, s = i & 127; sguW[i] = f2bf(s <= t ? args.in[18][i] : 0.f); }
        const float* x = args.in[0];
        for (int m0 = gw; m0 < MTOK; m0 += 4 * NGW) {
            f32x4 v[4][4];
#pragma unroll
            for (int r = 0; r < 4; ++r) { const int m = min(m0 + r * NGW, MTOK - 1); const f32x4* xr = (const f32x4*)(x + (size_t)m * DM) + 2 * lane;
#pragma unroll
                for (int j = 0; j < 2; ++j) { v[r][2 * j] = xr[128 * j]; v[r][2 * j + 1] = xr[128 * j + 1]; } }
#pragma unroll
            for (int r = 0; r < 4; ++r) { const int m = m0 + r * NGW; if (m < MTOK) {
                float sq = 0.f; u32x4* o16 = (u32x4*)(xb + (size_t)m * DM) + lane;
#pragma unroll
                for (int j = 0; j < 2; ++j) { const f32x4 t = v[r][2 * j], t2 = v[r][2 * j + 1];
                    sq += ((t.x * t.x + t.y * t.y) + (t.z * t.z + t.w * t.w)) + ((t2.x * t2.x + t2.y * t2.y) + (t2.z * t2.z + t2.w * t2.w));
                    u32x4 w; w.x = pk2(t.x, t.y); w.y = pk2(t.z, t.w); w.z = pk2(t2.x, t2.y); w.w = pk2(t2.z, t2.w); o16[64 * j] = w; }
                sq = wave_sum(sq);
                if (lane == 0) *(f32x4*)(ssq + (size_t)m * 4) = (f32x4){sq, 0.f, 0.f, 0.f}; } }
        }
    }
#endif
    GRID_SYNC();

    for (int layer = 0; layer < DEPTH; ++layer) {
        const bf16* Wl = (const bf16*)(ws + WS_W + (size_t)layer * WL_SIZE);
        for (int half = 0; half < 2; ++half) {
#if PH & 2
#ifndef UPREP
#define UPREP 1
#endif
            for (int rep_ = 0; rep_ < UPREP; ++rep_) {
                pg8::Gemm g{xb, Wl + (half ? WL_GU2 : WL_GU1) / 2, MTOK, NGU, DM}; pg8::StaticOrder S; S.init(MTOK, NGU, G, bid);
                if (lane0_()) *(LAS int*)((LAS float*)(lds + 135168) + wave * 132 + 128) = -1;
                EpiSwiglu E{actb, ssq + (size_t)(3 * layer + 2 * half) * MTOK * 4, (LAS float*)(lds + 135168)};
                pg8::gemm_phase<EpiSwiglu, pg8::StaticOrder, true, true>(lds, g, S, E);
            }
            GRID_SYNC();
            {
                pg8::Gemm g{actb, Wl + (half ? WL_D2 : WL_D1) / 2, MTOK, DM, DFF}; pg8::StaticOrder S; S.init(MTOK, DM, G, bid);
                EpiResid E{xb, ssq + (size_t)(3 * layer + 2 * half + 1) * MTOK * 4, 0.5f, (LAS float*)(lds + 131072)};
                pg8::gemm_phase<EpiResid, pg8::StaticOrder, true, true>(lds, g, S, E);
            }
            GRID_SYNC();
            if (half == 1) break;

#endif
#if PH & 4
            {
                pg8::Gemm g{xb, Wl + WL_IN / 2, MTOK, 2560, DM}; pg8::StaticOrder S; S.init(MTOK, 2560, G, bid);
                if (lane0_()) *(LAS int*)((LAS float*)(lds + 135168) + wave * 132 + 128) = -1;
                EpiProj E{proj, ssq + (size_t)(3 * layer + 1) * MTOK * 4, (LAS float*)(lds + 135168)};
                pg8::gemm_phase<EpiProj, pg8::StaticOrder, true, true>(lds, g, S, E);
            }
            {
                PHASE_IDS();
                const float* ssq_in = ssq + (size_t)(3 * layer + 1) * MTOK * 4;
                const bf16* wdt = Wl + WL_IN / 2 + (size_t)(2560 + r16) * DM + q4 * 8;
                for (int rb = gw; rb < MTOK / 16; rb += NGW) {
                    const bf16* xa = xb + (size_t)(rb * 16 + r16) * DM + q4 * 8;
                    f32x4 acc = (f32x4){0.f, 0.f, 0.f, 0.f};
#pragma unroll 8
                    for (int ks = 0; ks < 32; ++ks) acc = mfma16(*(const bf16x8*)(xa + ks * 32), *(const bf16x8*)(wdt + ks * 32), acc);
                    if (r16 < 8) {
#pragma unroll
                        for (int j = 0; j < 4; ++j) { const unsigned row = rb * 16 + q4 * 4 + j; dtraw[row * 8u + r16] = acc[j] * row_rstd(ssq_in, row); }
                    }
                }
            }
            GRID_SYNC();

            const float* conv_w = args.in[7] + layer * 4 * 1024; const float* conv_b = args.in[8] + layer * 1024;
#endif
#ifndef MIXREP
#define MIXREP 1
#endif
#ifndef REPMASK
#define REPMASK 0
#endif
            for (int rep_ = 0; rep_ < MIXREP; ++rep_) {
#if PH & 8
            for (int rp_ = 0; rp_ < ((REPMASK & 8) ? 2 : 1); ++rp_)
            for (int unit = bid; unit < BATCH * NCH * 2; unit += G) {
                PHASE_IDS();
                const int g2 = unit & 1, c = (unit >> 1) & 31, b = unit >> 6;
                const size_t grow0 = (size_t)b * SEQ + c * 128;
                LAS bf16* xT = (LAS bf16*)lds;
                LAS bf16* BTs = (LAS bf16*)(lds + 69632);
                LAS float* s_dt = (LAS float*)(lds + 104448); LAS float* s_acs = s_dt + 512;
                u32x4 Rraw[19]; f32x4 Rw[8]; f32x4 Rb[2]; float dx[4] = {0.f, 0.f, 0.f, 0.f};
#pragma unroll
                for (int i = 0; i < 19; ++i) Rraw[i] = (u32x4){0u, 0u, 0u, 0u};
#pragma unroll
                for (int i = 0; i < 8; ++i) Rw[i] = (f32x4){0.f, 0.f, 0.f, 0.f};
                Rb[0] = (f32x4){0.f, 0.f, 0.f, 0.f}; Rb[1] = (f32x4){0.f, 0.f, 0.f, 0.f};
                const int cgi = tid >> 3, l0 = (tid & 7) * 16;
                if (wave < 4) conv_load(Rraw, Rw, Rb, proj, conv_w, conv_b, PC_XBC + g2 * 256 + cgi * 8, grow0, c, l0);
                else if (wave < 6) conv_load(Rraw, Rw, Rb, proj, conv_w, conv_b, PC_XBC + 512 + g2 * 128 + (cgi - 32) * 8, grow0, c, l0);
                else {
#pragma unroll
                    for (int k = 0; k < 2; ++k) { const int h = g2 * 4 + (wave - 6) * 2 + k; const float dtb = args.in[9][layer * 8 + h];
                        dx[2 * k] = dtraw[(grow0 + 2 * lane) * 8 + h] + dtb; dx[2 * k + 1] = dtraw[(grow0 + 2 * lane + 1) * 8 + h] + dtb; }
#pragma unroll
                    for (int k = 0; k < 2; ++k) { const int hh = (wave - 6) * 2 + k; ssd_dt_acs_wave(dx[2 * k], dx[2 * k + 1], -__expf(args.in[10][layer * 8 + g2 * 4 + hh]), s_dt + hh * 128, s_acs + hh * 128, lane); }
                }
                __syncthreads();
                if (wave < 4) {
                    const int hh = cgi >> 3, pl = (cgi & 7) * 8; const float acs_end = s_acs[hh * 128 + 127];
                    LAS bf16* dst = xT + hh * (64 * 136);
                    conv_apply(Rraw, Rw, Rb, l0, [&](int l, const float (&o)[8]) {
                        const float sc = s_dt[hh * 128 + l] * __expf(acs_end - s_acs[hh * 128 + l]);
#pragma unroll
                        for (int i = 0; i < 8; ++i) dst[(pl + i) * 136 + l] = f2bf(o[i] * sc); });
                } else if (wave < 6) {
                    const int nl = (cgi - 32) * 8;
                    conv_apply(Rraw, Rw, Rb, l0, [&](int l, const float (&o)[8]) {
#pragma unroll
                        for (int i = 0; i < 8; ++i) BTs[(nl + i) * 136 + l] = f2bf(o[i]); });
                }
                __syncthreads();
                {
                    bf16x8 bfr[4];
#pragma unroll
                    for (int ks = 0; ks < 4; ++ks) bfr[ks] = lds_frag(BTs, 16 * wave + r16, 136, ks * 32 + q4 * 8);
#pragma unroll
                    for (int hh = 0; hh < 4; ++hh) {
                        f32x4 acc[4];
#pragma unroll
                        for (int pt = 0; pt < 4; ++pt) acc[pt] = (f32x4){0.f, 0.f, 0.f, 0.f};
#pragma unroll
                        for (int ks = 0; ks < 4; ++ks)
#pragma unroll
                            for (int pt = 0; pt < 4; ++pt) acc[pt] = mfma16(bfr[ks], lds_frag(xT + hh * (64 * 136), 16 * pt + r16, 136, ks * 32 + q4 * 8), acc[pt]);
                        const int unit8 = ((b * NCH + c) * 8) + g2 * 4 + hh;
                        float* st = ST + (size_t)unit8 * 8192;
#pragma unroll
                        for (int pt = 0; pt < 4; ++pt) *(f32x4*)(st + (16 * pt + r16) * 128 + 16 * wave + q4 * 4) = acc[pt];
                    }
                }
                if (tid < 4) CD[((b * NCH + c) * 2 + g2) * 32 + tid] = __expf(s_acs[tid * 128 + 127]);
                __syncthreads();
            }
#endif
#if PH & 16
            for (int rp_ = 0; rp_ < ((REPMASK & 16) ? 2 : 1); ++rp_)
            for (int unit = bid; unit < BATCH * NCH; unit += G) {
                PHASE_IDS();
                const int nb = unit & 31, b = unit >> 5;
                const size_t grow0 = (size_t)b * SEQ + nb * 128;
                LAS bf16* Ks = (LAS bf16*)lds; LAS bf16* VT = (LAS bf16*)(lds + 36864); LAS bf16* Ps = (LAS bf16*)(lds + 72704) + wave * (16 * 168);
                LAS float* s_bias = (LAS float*)(lds + 115712);
                s_bias[tid] = args.in[14][T5_BUCKET[tid & 127] * 4 + (tid >> 7)];
                for (int it = tid; it < 64 * 24; it += 512) { const int d = it / 24, j = 256 + it % 24; VT[d * 280 + j] = 0; }
                f32x4 og[4][4]; float ssr[4] = {0.f, 0.f, 0.f, 0.f};
#pragma unroll
                for (int kvh = 0; kvh < 2; ++kvh) {
                    if (kvh) __syncthreads();
                    {
                        u32x4 kq[4], vq[4];
#pragma unroll
                        for (int k = 0; k < 4; ++k) {
                            const int it = tid + 512 * k, j = it >> 3, d8 = (it & 7) * 8;
                            kq[k] = (u32x4){0u, 0u, 0u, 0u}; vq[k] = (u32x4){0u, 0u, 0u, 0u};
                            if (nb > 0 || j >= 128) { const bf16* src = proj + (grow0 + j - 128) * NPROJ + kvh * 64 + d8; kq[k] = *(const u32x4*)(src + PC_K); vq[k] = *(const u32x4*)(src + PC_V); }
                        }
#pragma unroll
                        for (int k = 0; k < 4; ++k) {
                            const int it = tid + 512 * k, j = it >> 3, d8 = (it & 7) * 8;
                            *(LAS u32x4*)(Ks + j * 72 + d8) = kq[k];
                            const unsigned vw[4] = {vq[k].x, vq[k].y, vq[k].z, vq[k].w};
#pragma unroll
                            for (int i = 0; i < 4; ++i) { VT[(d8 + 2 * i) * 280 + j] = (bf16)(vw[i] & 0xffffu); VT[(d8 + 2 * i + 1) * 280 + j] = (bf16)(vw[i] >> 16); }
                        }
                    }
                    __syncthreads();
#pragma unroll
                    for (int g = 0; g < 2; ++g) {
                        const int hq = kvh * 2 + g;
                        const float sink = args.in[13][layer * 4 + hq];
                        const bf16* qp = proj + (grow0 + 16 * wave + r16) * NPROJ + PC_Q + hq * 64 + q4 * 8;
                        const bf16x8 aq0 = *(const bf16x8*)qp, aq1 = *(const bf16x8*)(qp + 32);
                        f32x4 sc[9];
#pragma unroll
                        for (int kk = 0; kk < 9; ++kk) {
                            const int krow = 16 * (wave + kk) + r16;
                            f32x4 a = (f32x4){0.f, 0.f, 0.f, 0.f};
                            a = mfma16(aq0, lds_frag(Ks, krow, 72, q4 * 8), a);
                            a = mfma16(aq1, lds_frag(Ks, krow, 72, 32 + q4 * 8), a);
                            sc[kk] = a;
                        }
                        float sm[4];
#pragma unroll
                        for (int j = 0; j < 4; ++j) {
                            const int i = 16 * wave + q4 * 4 + j; float m = -INFINITY;
#pragma unroll
                            for (int kk = 0; kk < 9; ++kk) {
                                const int jk = 16 * (wave + kk) + r16, dist = i - jk + 128;
                                const bool ok = (dist >= 0) && (dist < 128) && (nb > 0 || jk >= 128);
                                const float sv = ok ? sc[kk][j] * 0.125f + s_bias[hq * 128 + (dist & 127)] : -INFINITY;
                                sc[kk][j] = sv; m = fmaxf(m, sv);
                            }
                            m = fmaxf(max16(m), sink);
                            float su = 0.f;
#pragma unroll
                            for (int kk = 0; kk < 9; ++kk) { const float p = __expf(sc[kk][j] - m); sc[kk][j] = p; su += p; }
                            sm[j] = sum16(su) + __expf(sink - m);
                        }
#pragma unroll
                        for (int kk = 0; kk < 9; ++kk)
#pragma unroll
                            for (int j = 0; j < 4; ++j) Ps[(q4 * 4 + j) * 168 + kk * 16 + r16] = f2bf(sc[kk][j]);
                        *(LAS u32x2*)(Ps + (lane >> 2) * 168 + 144 + (lane & 3) * 4) = (u32x2){0u, 0u};
                        f32x4 oa[4];
#pragma unroll
                        for (int dt = 0; dt < 4; ++dt) oa[dt] = (f32x4){0.f, 0.f, 0.f, 0.f};
#pragma unroll
                        for (int ks = 0; ks < 5; ++ks) {
                            const bf16x8 pa = lds_frag(Ps, r16, 168, ks * 32 + q4 * 8);
#pragma unroll
                            for (int dt = 0; dt < 4; ++dt) oa[dt] = mfma16(pa, lds_frag(VT, 16 * dt + r16, 280, 16 * wave + ks * 32 + q4 * 8), oa[dt]);
                        }
#pragma unroll
                        for (int j = 0; j < 4; ++j) { const float inv = 1.f / sm[j];
#pragma unroll
                            for (int dt = 0; dt < 4; ++dt) { const float o = oa[dt][j] * inv; ssr[j] += o * o; og[hq][dt][j] = o; } }
                    }
                }
#pragma unroll
                for (int hq = 0; hq < 4; ++hq) {
#pragma unroll
                    for (int j = 0; j < 4; ++j) {
                        const size_t row = grow0 + 16 * wave + q4 * 4 + j; float ss = 0.f;
#pragma unroll
                        for (int dt = 0; dt < 4; ++dt) { const float o = og[hq][dt][j]; ss += o * o; Yg[row * DM + 512 + hq * 64 + 16 * dt + r16] = f2bf(o); }
                        ss = sum16(ss);
                        if (r16 == 0) mss_a[(size_t)hq * MTOK + row] = ss;
                    }
                }
                __syncthreads();
            }
#endif
#if PH & 32
            for (int rp_ = 0; rp_ < ((REPMASK & 32) ? 2 : 1); ++rp_)
            for (int unit = bid; unit < BATCH * NCH; unit += G) {
                PHASE_IDS();
                const int c = unit & 31, b = unit >> 5;
                const size_t grow0 = (size_t)b * SEQ + c * 128;
                LAS bf16* vnT = (LAS bf16*)lds;
                LAS bf16* Us = (LAS bf16*)(lds + 69632);
                const int l = tid >> 2, sub = tid & 3;
                u32x4 gvr[8], ur[8]; bf16x8 wa[4][4];
                {
                    const bf16* src = proj + (grow0 + l) * NPROJ + PC_GV + sub * 64;
#pragma unroll
                    for (int k = 0; k < 8; ++k) gvr[k] = *(const u32x4*)(src + 8 * k);
#pragma unroll
                    for (int k = 0; k < 8; ++k) { const int it = tid + 512 * k, t = it >> 5, c8 = (it & 31) * 8; ur[k] = *(const u32x4*)(proj + (grow0 + t) * NPROJ + PC_U + c8); }
                }
                {
                    float v[64]; float sm = 0.f;
#pragma unroll
                    for (int k = 0; k < 8; ++k) { float t8[8]; unpack8(gvr[k], t8);
#pragma unroll
                        for (int i = 0; i < 8; ++i) { v[8 * k + i] = gelu_f(t8[i]); sm += v[8 * k + i]; } }
                    sm += __shfl_xor(sm, 1); sm += __shfl_xor(sm, 2);
                    const float mean = sm * (1.f / 256.f); float qv = 0.f;
#pragma unroll
                    for (int i = 0; i < 64; ++i) { const float d = v[i] - mean; qv += d * d; }
                    qv += __shfl_xor(qv, 1); qv += __shfl_xor(qv, 2);
                    const float rstd = rsqrtf(qv * (1.f / 256.f) + EPS);
                    const float* lw = args.in[16] + layer * 256 + sub * 64; const float* lb = args.in[17] + layer * 256 + sub * 64;
                    LAS bf16* dst = vnT + sub * (64 * 136) + l;
#pragma unroll
                    for (int i = 0; i < 64; ++i) dst[i * 136] = f2bf((v[i] - mean) * rstd * lw[i] + lb[i]);
                }
#pragma unroll
                for (int k = 0; k < 8; ++k) { const int it = tid + 512 * k, t = it >> 5, c8 = (it & 31) * 8; *(LAS u32x4*)(Us + t * 264 + c8) = ur[k]; }
#pragma unroll
                for (int gi = 0; gi < 4; ++gi)
#pragma unroll
                    for (int ks = 0; ks < 4; ++ks) wa[gi][ks] = *(const bf16x8*)(sguW + (size_t)(layer * 4 + gi) * 16384 + (16 * wave + r16) * 128 + ks * 32 + q4 * 8);
                __syncthreads();
                {
                    f32x4 og[4][4]; float ss[4] = {0.f, 0.f, 0.f, 0.f};
#pragma unroll
                    for (int gi = 0; gi < 4; ++gi) {
                        f32x4 acc[4];
#pragma unroll
                        for (int dt = 0; dt < 4; ++dt) acc[dt] = (f32x4){0.f, 0.f, 0.f, 0.f};
#pragma unroll
                        for (int ks = 0; ks < 4; ++ks) {
                            if (2 * ks <= wave) {
#pragma unroll
                                for (int dt = 0; dt < 4; ++dt) acc[dt] = mfma16(wa[gi][ks], lds_frag(vnT + gi * (64 * 136), 16 * dt + r16, 136, ks * 32 + q4 * 8), acc[dt]);
                            }
                        }
#pragma unroll
                        for (int j = 0; j < 4; ++j) {
                            const int t = 16 * wave + q4 * 4 + j; const float bs = args.in[19][(layer * 4 + gi) * 128 + t];
#pragma unroll
                            for (int dt = 0; dt < 4; ++dt) {
                                const float uu = gelu_f(bf2f(Us[t * 264 + gi * 64 + 16 * dt + r16]));
                                const float o = uu * (acc[dt][j] + bs); ss[j] += o * o; og[gi][dt][j] = o;
                            }
                        }
                    }
                    float rs[4];
#pragma unroll
                    for (int j = 0; j < 4; ++j) rs[j] = rsqrtf(sum16(ss[j]) * (1.f / 256.f) + EPS);
#pragma unroll
                    for (int gi = 0; gi < 4; ++gi)
#pragma unroll
                        for (int dt = 0; dt < 4; ++dt) {
                            const int col = gi * 64 + 16 * dt + r16; const float nw = args.in[20][layer * 256 + col];
#pragma unroll
                            for (int j = 0; j < 4; ++j) ycat[(grow0 + 16 * wave + q4 * 4 + j) * DM + 768 + col] = f2bf(og[gi][dt][j] * rs[j] * nw);
                        }
                }
                __syncthreads();
            }
            GRID_SYNC();
#endif
#if PH & 64
            for (int rp_ = 0; rp_ < ((REPMASK & 64) ? 2 : 1); ++rp_)
            { PHASE_IDS();
            for (int e = bid * 512 + tid; e < BATCH * 8 * 2048; e += G * 512) {
                const int i4 = e & 2047, h = (e >> 11) & 7, b = e >> 14;
                f32x4 carry = (f32x4){0.f, 0.f, 0.f, 0.f};
#pragma unroll 8
                for (int c = 0; c < NCH; ++c) {
                    const int unit = (b * NCH + c) * 8 + h;
                    const f32x4 st = *(const f32x4*)(ST + (size_t)unit * 8192 + i4 * 4); const float dec = CD[((b * NCH + c) * 2 + (h >> 2)) * 32 + (h & 3)];
                    u32x2 w; w.x = pk2(carry.x, carry.y); w.y = pk2(carry.z, carry.w); *(u32x2*)(PV + (size_t)unit * 8192 + i4 * 4) = w;
                    carry = carry * dec + st;
                }
            } }
            GRID_SYNC();
#endif
#if PH & 128
            for (int rp_ = 0; rp_ < ((REPMASK & 128) ? 2 : 1); ++rp_)
            for (int unit = bid; unit < BATCH * NCH * 2; unit += G) {
                PHASE_IDS();
                const int g2 = unit & 1, c = (unit >> 1) & 31, b = unit >> 6;
                const size_t grow0 = (size_t)b * SEQ + c * 128;
                LAS bf16* Cs = (LAS bf16*)lds; LAS bf16* Bs = (LAS bf16*)(lds + 34816); LAS bf16* Ms = Bs;
                LAS bf16* xT = (LAS bf16*)(lds + 69632);
                LAS float* s_dt = (LAS float*)(lds + 139264); LAS float* s_acs = s_dt + 512;
                u32x4 Rraw[19]; f32x4 Rw[8]; f32x4 Rb[2]; float dx0 = 0.f, dx1 = 0.f;
                const int cgi = tid >> 3, l0 = (tid & 7) * 16;
                if (wave < 4) {
                    conv_load(Rraw, Rw, Rb, proj, conv_w, conv_b, PC_XBC + g2 * 256 + cgi * 8, grow0, c, l0);
                    const int h = g2 * 4 + wave; const float dtb = args.in[9][layer * 8 + h];
                    dx0 = dtraw[(grow0 + 2 * lane) * 8 + h] + dtb; dx1 = dtraw[(grow0 + 2 * lane + 1) * 8 + h] + dtb;
                } else if (wave < 6) conv_load(Rraw, Rw, Rb, proj, conv_w, conv_b, PC_XBC + 512 + g2 * 128 + (cgi - 32) * 8, grow0, c, l0);
                else conv_load(Rraw, Rw, Rb, proj, conv_w, conv_b, PC_XBC + 768 + g2 * 128 + (cgi - 48) * 8, grow0, c, l0);
                if (wave < 4) {
                    const int hh = cgi >> 3, pl = (cgi & 7) * 8;
                    LAS bf16* dst = xT + hh * (64 * 136);
                    conv_apply(Rraw, Rw, Rb, l0, [&](int l, const float (&o)[8]) {
#pragma unroll
                        for (int i = 0; i < 8; ++i) dst[(pl + i) * 136 + l] = f2bf(o[i]); });
                    ssd_dt_acs_wave(dx0, dx1, -__expf(args.in[10][layer * 8 + g2 * 4 + wave]), s_dt + wave * 128, s_acs + wave * 128, lane);
                } else if (wave < 6) {
                    const int nl = (cgi - 32) * 8;
                    conv_apply(Rraw, Rw, Rb, l0, [&](int l, const float (&o)[8]) { *(LAS u32x4*)(Bs + l * 136 + nl) = pack8(o); });
                } else {
                    const int nl = (cgi - 48) * 8;
                    conv_apply(Rraw, Rw, Rb, l0, [&](int l, const float (&o)[8]) { *(LAS u32x4*)(Cs + l * 136 + nl) = pack8(o); });
                }
                __syncthreads();
                {
                    const int lrow = 16 * wave + r16;
                    bf16x8 ca[4];
#pragma unroll
                    for (int ks = 0; ks < 4; ++ks) ca[ks] = lds_frag(Cs, lrow, 136, ks * 32 + q4 * 8);
                    f32x4 cbr[8];
#pragma unroll
                    for (int st = 0; st < 8; ++st) {
                        cbr[st] = (f32x4){0.f, 0.f, 0.f, 0.f};
                        if (st <= wave) {
#pragma unroll
                            for (int ks = 0; ks < 4; ++ks) cbr[st] = mfma16(ca[ks], lds_frag(Bs, 16 * st + r16, 136, ks * 32 + q4 * 8), cbr[st]);
                        }
                    }
                    __syncthreads();
#pragma unroll 1
                    for (int hh = 0; hh < 4; ++hh) {
                        const int h = g2 * 4 + hh; const int unit8 = ((b * NCH + c) * 8) + h;
                        bf16x8 pvf[4][4];
                        {
                            const bf16* pv = PV + (size_t)unit8 * 8192;
#pragma unroll
                            for (int ks = 0; ks < 4; ++ks)
#pragma unroll
                                for (int pt = 0; pt < 4; ++pt) pvf[ks][pt] = *(const bf16x8*)(pv + (16 * pt + r16) * 128 + ks * 32 + q4 * 8);
                        }
                        bf16 zr[4][4];
#pragma unroll
                        for (int j = 0; j < 4; ++j)
#pragma unroll
                            for (int pt = 0; pt < 4; ++pt) zr[j][pt] = proj[(grow0 + 16 * wave + q4 * 4 + j) * NPROJ + PC_Z + h * 64 + 16 * pt + r16];
                        const LAS float* hdt = s_dt + hh * 128; const LAS float* hacs = s_acs + hh * 128;
                        float acl[4];
#pragma unroll
                        for (int j = 0; j < 4; ++j) acl[j] = hacs[16 * wave + q4 * 4 + j];
#pragma unroll
                        for (int st = 0; st < 8; ++st) {
                            if (st <= (wave | 1)) {
                                const int sI = 16 * st + r16; const float acss = hacs[sI], dts = hdt[sI];
#pragma unroll
                                for (int j = 0; j < 4; ++j) { const int l = 16 * wave + q4 * 4 + j; const float mv = (sI <= l) ? cbr[st][j] * __expf(fminf(acl[j] - acss, 0.f)) * dts : 0.f; Ms[l * 136 + sI] = f2bf(mv); }
                            }
                        }
                        f32x4 yo[4], yd[4];
#pragma unroll
                        for (int pt = 0; pt < 4; ++pt) { yo[pt] = (f32x4){0.f, 0.f, 0.f, 0.f}; yd[pt] = (f32x4){0.f, 0.f, 0.f, 0.f}; }
                        const LAS bf16* xh = xT + hh * (64 * 136);
#pragma unroll
                        for (int ks = 0; ks < 4; ++ks) {
                            if (2 * ks <= wave) {
                                const bf16x8 ma = lds_frag(Ms, lrow, 136, ks * 32 + q4 * 8);
#pragma unroll
                                for (int pt = 0; pt < 4; ++pt) yd[pt] = mfma16(ma, lds_frag(xh, 16 * pt + r16, 136, ks * 32 + q4 * 8), yd[pt]);
                            }
                        }
#pragma unroll
                        for (int ks = 0; ks < 4; ++ks)
#pragma unroll
                            for (int pt = 0; pt < 4; ++pt) yo[pt] = mfma16(ca[ks], pvf[ks][pt], yo[pt]);
                        const float Dh = args.in[11][layer * 8 + h];
#pragma unroll
                        for (int j = 0; j < 4; ++j) {
                            const int l = 16 * wave + q4 * 4 + j; const size_t row = grow0 + l; const float ea = __expf(acl[j]); float ss = 0.f;
#pragma unroll
                            for (int pt = 0; pt < 4; ++pt) {
                                const int p = 16 * pt + r16;
                                const float y = yd[pt][j] + ea * yo[pt][j] + Dh * bf2f(xh[p * 136 + l]);
                                const float o = y * silu_f(bf2f(zr[j][pt])); ss += o * o; Yg[row * DM + h * 64 + p] = f2bf(o);
                            }
                            ss = sum16(ss);
                            if (r16 == 0) mss_g[((size_t)g2 * MTOK + row) * 4 + hh] = ss;
                        }
                    }
                }
                __syncthreads();
            }
            GRID_SYNC();
#endif
#if PH & 256
            for (int rp_ = 0; rp_ < ((REPMASK & 256) ? 2 : 1); ++rp_)
            for (int m0 = gw; m0 < MTOK; m0 += 4 * NGW) {
                PHASE_IDS();
                f32x4 sv[4][3]; u32x4 yv[4][2];
                const int colA = lane * 8, colB = 512 + lane * 8;
#pragma unroll
                for (int r = 0; r < 4; ++r) { const int m = min(m0 + r * NGW, MTOK - 1);
                    sv[r][0] = *(const f32x4*)(mss_g + (size_t)m * 4); sv[r][1] = *(const f32x4*)(mss_g + ((size_t)MTOK + m) * 4); sv[r][2] = (f32x4){mss_a[m], mss_a[(size_t)MTOK + m], mss_a[(size_t)2 * MTOK + m], mss_a[(size_t)3 * MTOK + m]};
                    yv[r][0] = *(const u32x4*)(Yg + (size_t)m * DM + colA); yv[r][1] = *(const u32x4*)(Yg + (size_t)m * DM + 512 + (lane & 31) * 8); }
                float nwA[8], nwB[8];
                { const float* p = args.in[12] + layer * 512 + colA;
#pragma unroll
                  for (int i = 0; i < 8; ++i) nwA[i] = p[i];
                  const float* q = args.in[15] + layer * 256 + (lane & 31) * 8;
#pragma unroll
                  for (int i = 0; i < 8; ++i) nwB[i] = q[i]; }
#pragma unroll
                for (int r = 0; r < 4; ++r) { const int m = m0 + r * NGW; if (m < MTOK) {
                    const f32x4 s0 = sv[r][0], s1 = sv[r][1], s2 = sv[r][2];
                    const float r_ssd = rsqrtf((((s0.x + s0.y) + (s0.z + s0.w)) + ((s1.x + s1.y) + (s1.z + s1.w))) * (1.f / 512.f) + EPS);
                    const float r_att = rsqrtf(((s2.x + s2.y) + (s2.z + s2.w)) * (1.f / 256.f) + EPS);
                    float v[8]; unpack8(yv[r][0], v);
#pragma unroll
                    for (int i = 0; i < 8; ++i) v[i] = v[i] * r_ssd * nwA[i];
                    *(u32x4*)(ycat + (size_t)m * DM + colA) = pack8(v);
                    if (lane < 32) { unpack8(yv[r][1], v);
#pragma unroll
                        for (int i = 0; i < 8; ++i) v[i] = v[i] * r_att * nwB[i];
                        *(u32x4*)(ycat + (size_t)m * DM + colB) = pack8(v); } } }
            }
            GRID_SYNC();
#endif
            }
#if PH & 512
            {
                pg8::Gemm g{ycat, Wl + WL_OUT / 2, MTOK, DM, DM}; pg8::StaticOrder S; S.init(MTOK, DM, G, bid);
                EpiResid E{xb, ssq + (size_t)(3 * layer + 2) * MTOK * 4, 1.0f, (LAS float*)(lds + 131072)};
                pg8::gemm_phase<EpiResid, pg8::StaticOrder, true, true>(lds, g, S, E);
            }
            GRID_SYNC();
#endif
        }
    }
#if PH & 1024
    for (int m0 = gw; m0 < MTOK; m0 += 4 * NGW) {
        PHASE_IDS();
        u32x4 xv[4][2]; f32x4 pv4[4];
#pragma unroll
        for (int r = 0; r < 4; ++r) { const int m = min(m0 + r * NGW, MTOK - 1);
            const u32x4* xr = (const u32x4*)(xb + (size_t)m * DM) + lane; xv[r][0] = xr[0]; xv[r][1] = xr[64];
            pv4[r] = *(const f32x4*)(ssq + (size_t)6 * MTOK * 4 + (size_t)m * 4); }
        const f32x4* wv = (const f32x4*)args.in[26];
        f32x4 wq[2][2];
#pragma unroll
        for (int j = 0; j < 2; ++j) { const int c4 = (64 * j + lane) * 2; wq[j][0] = wv[c4]; wq[j][1] = wv[c4 + 1]; }
#pragma unroll
        for (int r = 0; r < 4; ++r) { const int m = m0 + r * NGW; if (m < MTOK) {
            const float rs = rstd4(pv4[r]); f32x4* orow = (f32x4*)(args.out + (size_t)m * DM);
#pragma unroll
            for (int j = 0; j < 2; ++j) {
                float v[8]; unpack8(xv[r][j], v);
                const int c4 = (64 * j + lane) * 2; const f32x4 w0 = wq[j][0], w1 = wq[j][1];
                orow[c4] = (f32x4){v[0] * rs * w0.x, v[1] * rs * w0.y, v[2] * rs * w0.z, v[3] * rs * w0.w};
                orow[c4 + 1] = (f32x4){v[4] * rs * w1.x, v[5] * rs * w1.y, v[6] * rs * w1.z, v[7] * rs * w1.w};
            } } }
    }
#endif
}

extern "C" void kernel_launch(void* const* d_in, const int* in_sizes, int n_in, void* d_out, int out_size, void* d_ws, size_t ws_size, hipStream_t stream) {
    static int grid = 0;
    if (grid == 0) {
        if (n_in != 27 || out_size != MTOK * DM || ws_size < WS_END) { fprintf(stderr, "kernel_launch: unexpected shapes (n_in %d, out %d, ws %zu)\n", n_in, out_size, ws_size); grid = -1; return; }
        int dev = 0, cus = 0, per_cu = 0;
        hipGetDevice(&dev); hipDeviceGetAttribute(&cus, hipDeviceAttributeMultiprocessorCount, dev);
        if (hipFuncSetAttribute((const void*)fwd_megakernel, hipFuncAttributeMaxDynamicSharedMemorySize, LDS_BYTES) != hipSuccess) { fprintf(stderr, "kernel_launch: hipFuncSetAttribute failed\n"); grid = -1; return; }
        if (hipOccupancyMaxActiveBlocksPerMultiprocessor(&per_cu, (const void*)fwd_megakernel, 512, LDS_BYTES) != hipSuccess || per_cu < 1) { fprintf(stderr, "kernel_launch: occupancy query gave %d\n", per_cu); per_cu = 1; }
        (void)hipGetLastError();
        grid = cus * 1;
        fprintf(stderr, "kernel_launch: cus %d per_cu %d grid %d\n", cus, per_cu, grid);
    }
    if (grid < 0) return;
    if (hipMemsetAsync((char*)d_ws + WS_BAR, 0, XCD_BAR_WORDS * 4, stream) != hipSuccess) { fprintf(stderr, "kernel_launch: memset failed\n"); return; }
    Args a{};
    for (int i = 0; i < 27; ++i) a.in[i] = (const float*)d_in[i];
    a.out = (float*)d_out; a.ws = (unsigned char*)d_ws;
    void* kargs[] = {&a};
    hipError_t e = hipLaunchCooperativeKernel((const void*)fwd_megakernel, dim3(grid), dim3(512), kargs, LDS_BYTES, stream);
    if (e != hipSuccess) fprintf(stderr, "kernel_launch: cooperative launch failed: %s (grid %d)\n", hipGetErrorString(e), grid);
}
```

```cpp
#include <hip/hip_runtime.h>
#include <hip/hip_cooperative_groups.h>
#include <cstdio>
#include <cstdint>
namespace cg = cooperative_groups;
namespace pg8 {
#define PG8_LAS __attribute__((address_space(3)))
typedef unsigned short bf16_t;
typedef short bf16x8 __attribute__((ext_vector_type(8)));
typedef float f32x4 __attribute__((ext_vector_type(4)));
typedef unsigned u32x4 __attribute__((ext_vector_type(4)));
constexpr int BM = 256, BK = 64, HALF = 128, HTB = HALF * BK * 2  , STAGE_BYTES = 8 * HTB, NXCD = 8, WGM = 8;

__host__ __device__ __forceinline__ int lds_byte(int r, int c) { const int st = (r >> 4) * 2 + (c >> 5), rr = r & 15, cc = c & 31, ob = rr * 64 + cc * 2; return st * 1024 + (ob ^ (((ob >> 9) & 1) << 5)); }
__host__ __device__ __forceinline__ void stage_rc(int b, int& R, int& C) { const int st = b / 1024, sb = b % 1024, swz = sb ^ (((sb >> 9) & 1) << 5); R = (st >> 1) * 16 + swz / 64; C = (st & 1) * 32 + (swz % 64) / 2; }
__host__ __device__ __forceinline__ int perm32(int rho) { const int n = rho >> 4, i = rho & 15; return 8 * (i >> 2) + 4 * n + (i & 3); }

struct Unit { int pm, pn; };
struct Gemm { const bf16_t* A; const bf16_t* Bt; int M, N, K; };

struct StaticOrder {
    int nM, nN, nwg, G, c;
    __host__ __device__ void init(int M, int N, int G_, int c_) { nM = M / BM; nN = N / BM; nwg = nM * nN; G = G_; c = c_; }
    __host__ __device__ bool next(int i, Unit& u) const {
        const long L = (long)i * G + c; if (L >= nwg) return false;
        int wgid = (int)L; { const int q = nwg / NXCD, r = nwg % NXCD, xcd = wgid % NXCD, off = wgid / NXCD; wgid = (xcd < r ? xcd * (q + 1) : r * (q + 1) + (xcd - r) * q) + off; }
        const int nig = WGM * nN, gid = wgid / nig, fm = gid * WGM, gsz = (nM - fm) < WGM ? (nM - fm) : WGM;
        u.pm = fm + ((wgid % nig) % gsz); u.pn = (wgid % nig) / gsz; return true;
    }
    __device__ __forceinline__ void a_ready(const Unit&) const {}
    __device__ __forceinline__ void done(const Unit&) const {}
};

__device__ __forceinline__ unsigned cvt_pk_bf16(float lo, float hi) { unsigned r; asm volatile("v_cvt_pk_bf16_f32 %0, %1, %2" : "=v"(r) : "v"(lo), "v"(hi)); return r; }
typedef float f32x2 __attribute__((ext_vector_type(2)));
template <class Epi, class Sched, bool ALIGN_EPI = false, bool SP2 = false>
__device__ __forceinline__ void gemm_phase(PG8_LAS unsigned char* lds, const Gemm g, const Sched& S, const Epi& E) {
    int tid_; asm volatile("v_mov_b32 %0, %1" : "=v"(tid_) : "v"((int)threadIdx.x));
    const int tid = tid_, wid = __builtin_amdgcn_readfirstlane(tid >> 6), lane = tid & 63, wr = wid >> 2, wc = wid & 3, fr = lane & 15, fq = lane >> 4;
    const int K = g.K, nt = K / BK;
    unsigned voffA[2], voffB[2];
#pragma unroll
    for (int i = 0; i < 2; ++i) { int R, C; stage_rc(tid * 16 + i * 8192, R, C); const int Rb = Epi::PERM ? ((R & ~31) + perm32(R & 31)) : R;
        voffA[i] = (unsigned)(R * K + C) * 2u; voffB[i] = (unsigned)(Rb * K + C) * 2u; }
    const size_t kstep = (size_t)(BK * 2);
    const size_t hstep = (size_t)HALF * K * 2;
    const size_t tstep = 2 * hstep;
    const unsigned ldsw = (unsigned)wid * 1024u;
    const int aoff = lds_byte(wr * 64 + fr, fq * 8), boff = lds_byte(wc * 32 + fr, fq * 8);
#define PG8_SA(b, h) (((b) * 2 + (h)) * HTB)
#define PG8_SB(b, h) ((4 + (b) * 2 + (h)) * HTB)
#define PG8_STAGE(bufoff, gbase, voff) do { _Pragma("unroll") for (int _i = 0; _i < 2; ++_i) \
        __builtin_amdgcn_global_load_lds((const unsigned*)((const char*)(gbase) + (voff)[_i]), (PG8_LAS unsigned*)(lds + (bufoff) + ldsw + _i * 8192), 16, 0, 0); } while (0)
#define PG8_LDA(dst, b, h) do { _Pragma("unroll") for (int m = 0; m < 4; ++m) _Pragma("unroll") for (int k = 0; k < 2; ++k) dst[m][k] = *(const PG8_LAS bf16x8*)(lds + PG8_SA(b, h) + aoff + m * 2048 + k * 1024); } while (0)
#define PG8_LDB(dst, b, h) do { _Pragma("unroll") for (int n = 0; n < 2; ++n) _Pragma("unroll") for (int k = 0; k < 2; ++k) dst[n][k] = *(const PG8_LAS bf16x8*)(lds + PG8_SB(b, h) + boff + n * 2048 + k * 1024); } while (0)
#define PG8_MMA(ai, bj, At, Bt) do { __builtin_amdgcn_s_setprio(1); _Pragma("unroll") for (int m = 0; m < 4; ++m) _Pragma("unroll") for (int n = 0; n < 2; ++n) _Pragma("unroll") for (int k = 0; k < 2; ++k) \
        acc[ai][bj][m][n] = __builtin_amdgcn_mfma_f32_16x16x32_bf16(Bt[n][k], At[m][k], acc[ai][bj][m][n], 0, 0, 0); __builtin_amdgcn_s_setprio(0); } while (0)
#define PG8_WAIT_V(n) asm volatile("s_waitcnt vmcnt(" #n ")" ::: "memory")
#define PG8_WAIT_L(n) asm volatile("s_waitcnt lgkmcnt(" #n ")" ::: "memory")
#define PG8_BAR __builtin_amdgcn_s_barrier()
#define PG8_SCHED __builtin_amdgcn_sched_barrier(0)
    Unit cur, nxt; int ui = 0;
    if (!S.next(0, cur)) return;
    f32x4 acc[2][2][4][2];
#pragma unroll
    for (int a = 0; a < 2; ++a)
#pragma unroll
        for (int b = 0; b < 2; ++b)
#pragma unroll
            for (int m = 0; m < 4; ++m)
#pragma unroll
                for (int n = 0; n < 2; ++n) acc[a][b][m][n] = (f32x4){0.f, 0.f, 0.f, 0.f};
    bf16x8 At[4][2], B0[2][2], B1[2][2];
    const char* cA = (const char*)g.A + (size_t)cur.pm * tstep; const char* cB = (const char*)g.Bt + (size_t)cur.pn * tstep;
    S.a_ready(cur);
    if constexpr (SP2) {
        PG8_STAGE(PG8_SB(0, 0), cB, voffB); PG8_STAGE(PG8_SB(0, 1), cB + hstep, voffB); PG8_STAGE(PG8_SA(0, 0), cA, voffA); PG8_STAGE(PG8_SA(0, 1), cA + hstep, voffA);
        if (wr == 1) PG8_BAR;
        PG8_WAIT_V(2); PG8_BAR;
        PG8_STAGE(PG8_SB(1, 0), cB + kstep, voffB); PG8_STAGE(PG8_SA(1, 0), cA + kstep, voffA); PG8_STAGE(PG8_SB(1, 1), cB + hstep + kstep, voffB);
        PG8_WAIT_V(6); PG8_BAR;
    } else {
        PG8_STAGE(PG8_SB(0, 0), cB, voffB); PG8_STAGE(PG8_SA(0, 0), cA, voffA); PG8_STAGE(PG8_SB(0, 1), cB + hstep, voffB); PG8_STAGE(PG8_SA(0, 1), cA + hstep, voffA);
        if (wr == 1) PG8_BAR;
        PG8_WAIT_V(4); PG8_BAR;
        PG8_STAGE(PG8_SB(1, 0), cB + kstep, voffB); PG8_STAGE(PG8_SA(1, 0), cA + kstep, voffA); PG8_STAGE(PG8_SB(1, 1), cB + hstep + kstep, voffB);
        PG8_WAIT_V(6); PG8_BAR;
    }
    for (;;) {
        const bool has_next = S.next(ui + 1, nxt);
        const char* nA = has_next ? (const char*)g.A + (size_t)nxt.pm * tstep : cA; const char* nB = has_next ? (const char*)g.Bt + (size_t)nxt.pn * tstep : cB;
        for (int t = 0; t < nt; t += 2) {
            const bool last = (t == nt - 2);
            const char* a1 = cA + (size_t)(t + 1) * kstep;
            const char* a2 = last ? nA : cA + (size_t)(t + 2) * kstep; const char* b2 = last ? nB : cB + (size_t)(t + 2) * kstep;
            const char* a3 = a2 + kstep; const char* b3 = b2 + kstep;
            if (last && has_next) S.a_ready(nxt);
            if constexpr (SP2) {
            PG8_LDB(B0, 0, 0); PG8_LDB(B1, 0, 1); PG8_SCHED; PG8_LDA(At, 0, 0); PG8_STAGE(PG8_SA(1, 1), a1 + hstep, voffA);
            PG8_WAIT_V(8); PG8_WAIT_L(0); PG8_BAR; PG8_MMA(0, 0, At, B0); PG8_MMA(0, 1, At, B1); PG8_BAR; PG8_SCHED;
            PG8_LDA(At, 0, 1); PG8_STAGE(PG8_SB(0, 0), b2, voffB); PG8_STAGE(PG8_SB(0, 1), b2 + hstep, voffB); PG8_STAGE(PG8_SA(0, 0), a2, voffA);
            PG8_WAIT_V(8); PG8_WAIT_L(0); PG8_BAR; PG8_MMA(1, 0, At, B0); PG8_MMA(1, 1, At, B1); PG8_BAR; PG8_SCHED;
            PG8_LDB(B0, 1, 0); PG8_LDB(B1, 1, 1); PG8_SCHED; PG8_LDA(At, 1, 0); PG8_STAGE(PG8_SA(0, 1), a2 + hstep, voffA);
            PG8_WAIT_V(8); PG8_WAIT_L(0); PG8_BAR; PG8_MMA(0, 0, At, B0); PG8_MMA(0, 1, At, B1); PG8_BAR; PG8_SCHED;
            PG8_LDA(At, 1, 1); PG8_STAGE(PG8_SB(1, 0), b3, voffB); PG8_STAGE(PG8_SB(1, 1), b3 + hstep, voffB); PG8_STAGE(PG8_SA(1, 0), a3, voffA);
            PG8_WAIT_V(8); PG8_WAIT_L(0); PG8_BAR; PG8_MMA(1, 0, At, B0); PG8_MMA(1, 1, At, B1); PG8_BAR; PG8_SCHED;
            } else {
            PG8_LDB(B0, 0, 0); PG8_SCHED; PG8_LDA(At, 0, 0); PG8_STAGE(PG8_SA(1, 1), a1 + hstep, voffA);
            PG8_WAIT_L(8); PG8_BAR; PG8_WAIT_L(0); PG8_MMA(0, 0, At, B0); PG8_BAR; PG8_SCHED;
            PG8_LDB(B1, 0, 1); PG8_STAGE(PG8_SB(0, 0), b2, voffB);
            PG8_BAR; PG8_WAIT_L(0); PG8_MMA(0, 1, At, B1); PG8_BAR;
            PG8_LDA(At, 0, 1); PG8_STAGE(PG8_SA(0, 0), a2, voffA);
            PG8_BAR; PG8_WAIT_L(0); PG8_MMA(1, 0, At, B0); PG8_BAR; PG8_SCHED;
            PG8_STAGE(PG8_SB(0, 1), b2 + hstep, voffB);
            PG8_WAIT_V(6); PG8_BAR; PG8_MMA(1, 1, At, B1); PG8_BAR;
            PG8_LDB(B0, 1, 0); PG8_SCHED; PG8_LDA(At, 1, 0); PG8_STAGE(PG8_SA(0, 1), a2 + hstep, voffA);
            PG8_WAIT_L(8); PG8_BAR; PG8_WAIT_L(0); PG8_MMA(0, 0, At, B0); PG8_BAR; PG8_SCHED;
            PG8_LDB(B1, 1, 1); PG8_STAGE(PG8_SB(1, 0), b3, voffB);
            PG8_BAR; PG8_WAIT_L(0); PG8_MMA(0, 1, At, B1); PG8_BAR;
            PG8_LDA(At, 1, 1); PG8_STAGE(PG8_SA(1, 0), a3, voffA);
            PG8_BAR; PG8_WAIT_L(0); PG8_MMA(1, 0, At, B0); PG8_BAR; PG8_SCHED;
            PG8_STAGE(PG8_SB(1, 1), b3 + hstep, voffB);
            PG8_WAIT_V(6); PG8_BAR; PG8_MMA(1, 1, At, B1); PG8_BAR;
            }
        }
        if constexpr (ALIGN_EPI) { if (wr == 0) PG8_BAR; }
        if constexpr (!Epi::AFTER_DRAIN) { E(acc, cur, wr, wc, fr, fq); S.done(cur); }
        if (!has_next) break;
#pragma unroll
        for (int a = 0; a < 2; ++a)
#pragma unroll
            for (int b = 0; b < 2; ++b)
#pragma unroll
                for (int m = 0; m < 4; ++m)
#pragma unroll
                    for (int n = 0; n < 2; ++n) acc[a][b][m][n] = (f32x4){0.f, 0.f, 0.f, 0.f};
        cur = nxt; cA = nA; cB = nB; ++ui;
        if constexpr (ALIGN_EPI) { if (wr == 1) PG8_BAR; }
    }
    PG8_WAIT_V(0);
    if constexpr (!ALIGN_EPI) { if (wr == 0) PG8_BAR; }
    PG8_BAR;
    if constexpr (Epi::AFTER_DRAIN) { E.fused(acc, cur, wr, wc, fr, fq, lds, wid, lane); S.done(cur); }
#undef PG8_SA
#undef PG8_SB
#undef PG8_STAGE
#undef PG8_LDA
#undef PG8_LDB
#undef PG8_MMA
#undef PG8_WAIT_V
#undef PG8_WAIT_L
#undef PG8_BAR
#undef PG8_SCHED
}
}

#define LAS __attribute__((address_space(3)))
#define DI __device__ __forceinline__
typedef unsigned short bf16;
typedef short bf16x8 __attribute__((ext_vector_type(8)));
typedef float f32x4 __attribute__((ext_vector_type(4)));
typedef unsigned u32x4 __attribute__((ext_vector_type(4)));
typedef unsigned u32x2 __attribute__((ext_vector_type(2)));

constexpr int BATCH = 8, SEQ = 4096, DM = 1024, MTOK = BATCH * SEQ, DFF = 2816, DEPTH = 2;
constexpr int NGU = 2 * DFF;
constexpr int NPROJ = 2816;
constexpr int DINP = 2568;
constexpr int PC_Z = 0, PC_XBC = 512, PC_Q = 1536, PC_K = 1792, PC_V = 1920, PC_U = 2048, PC_GV = 2304, PC_DT = 2560;
constexpr int NCH = 32;
constexpr float EPS = 1e-6f;
constexpr size_t MiB = 1u << 20;
constexpr size_t WS_BAR = 65536, WS_CD = 0, WS_SSQ = 89 * MiB, WS_MSSQ = 3 * MiB, WS_DTRAW = 5 * MiB, WS_SGUW = 6 * MiB, WS_W = 8 * MiB;
constexpr size_t WL_GU1 = 0, WL_D1 = 11 * MiB, WL_IN = WL_D1 + 5632 * 1024, WL_OUT = WL_IN + 5632 * 1024, WL_GU2 = WL_OUT + 2 * MiB, WL_D2 = WL_GU2 + 11 * MiB, WL_SIZE = WL_D2 + 5632 * 1024;
constexpr size_t WS_XB = 96 * MiB, WS_ST = 96 * MiB, WS_ACT = 160 * MiB, WS_YG = 160 * MiB, WS_YCAT = 224 * MiB, WS_PV = 288 * MiB, WS_PROJ = 336 * MiB, WS_END = 512 * MiB;
static_assert(WS_W + 2 * WL_SIZE <= WS_XB, "weights fit");
constexpr int LDS_BYTES = 147456;
#ifndef PH
#define PH 2047
#endif

__device__ const unsigned char T5_BUCKET[128] = {0,1,2,3,4,5,6,7,8,9,10,11,12,13,14,15,16,16,16,17,17,18,18,18,19,19,19,20,20,20,20,21,21,21,21,22,22,22,22,22,23,23,23,23,23,23,24,24,24,24,24,24,25,25,25,25,25,25,25,26,26,26,26,26,26,26,26,27,27,27,27,27,27,27,27,27,27,28,28,28,28,28,28,28,28,28,28,29,29,29,29,29,29,29,29,29,29,29,29,30,30,30,30,30,30,30,30,30,30,30,30,30,30,31,31,31,31,31,31,31,31,31,31,31,31,31,31,31};

DI float bf2f(unsigned short b) { return __uint_as_float((unsigned)b << 16); }
typedef float f32x2_t __attribute__((ext_vector_type(2)));
typedef __bf16 bf16x2_t __attribute__((ext_vector_type(2)));
DI unsigned pk2(float lo, float hi) { const f32x2_t v = {lo, hi}; const bf16x2_t b = __builtin_convertvector(v, bf16x2_t); return __builtin_bit_cast(unsigned, b); }
DI unsigned short f2bf(float f) { return (unsigned short)(pk2(f, 0.f) & 0xffffu); }
DI void unpack8(u32x4 r, float (&v)[8]) {
    v[0] = __uint_as_float(r.x << 16); v[1] = __uint_as_float(r.x & 0xffff0000u); v[2] = __uint_as_float(r.y << 16); v[3] = __uint_as_float(r.y & 0xffff0000u);
    v[4] = __uint_as_float(r.z << 16); v[5] = __uint_as_float(r.z & 0xffff0000u); v[6] = __uint_as_float(r.w << 16); v[7] = __uint_as_float(r.w & 0xffff0000u);
}
DI u32x4 pack8(const float (&v)[8]) { u32x4 r; r.x = pk2(v[0], v[1]); r.y = pk2(v[2], v[3]); r.z = pk2(v[4], v[5]); r.w = pk2(v[6], v[7]); return r; }
DI float fast_sigmoid(float x) { return __builtin_amdgcn_rcpf(1.f + __builtin_amdgcn_exp2f(-1.4426950409f * x)); }
DI float silu_f(float x) { return x * fast_sigmoid(x); }
DI float gelu_f(float x) { const float u = 1.5957691216f * (x + 0.044715f * x * x * x); return x * fast_sigmoid(u); }
DI int opaque_tid() { int t; asm volatile("v_mov_b32 %0, %1" : "=v"(t) : "v"((int)threadIdx.x)); return t; }
#define PHASE_IDS() const int tid = opaque_tid(), lane = tid & 63, r16 = lane & 15, q4 = lane >> 4; (void)r16; (void)q4; (void)tid
DI bool lane0_() { return (opaque_tid() & 63) == 0; }
DI float wave_sum(float v) {
#pragma unroll
    for (int o = 1; o < 64; o <<= 1) v += __shfl_xor(v, o);
    return v;
}
DI float sum16(float v) { v += __shfl_xor(v, 1); v += __shfl_xor(v, 2); v += __shfl_xor(v, 4); v += __shfl_xor(v, 8); return v; }
DI float max16(float v) { v = fmaxf(v, __shfl_xor(v, 1)); v = fmaxf(v, __shfl_xor(v, 2)); v = fmaxf(v, __shfl_xor(v, 4)); v = fmaxf(v, __shfl_xor(v, 8)); return v; }
DI f32x4 mfma16(bf16x8 a, bf16x8 b, f32x4 c) { return __builtin_amdgcn_mfma_f32_16x16x32_bf16(a, b, c, 0, 0, 0); }
DI bf16x8 lds_frag(const LAS bf16* base, int row, int stride, int k) { return *(const LAS bf16x8*)(base + row * stride + k); }
DI float rstd4(f32x4 p) { return rsqrtf(((p.x + p.y) + (p.z + p.w)) * (1.f / DM) + EPS); }
DI float row_rstd(const float* ssq, unsigned row) { return rstd4(*(const f32x4*)(ssq + row * 4u)); }

using pg8::Unit;
DI void cached_rs8(float (&rs8)[8], const float* ssq, LAS float* rtab, const Unit& u, int wr, int wc, int fr, int fq) {
    LAS float* tab = rtab + (wr * 4 + wc) * 132;
    LAS int* tag = (LAS int*)(tab + 128);
    const int ln = fq * 16 + fr;
    if (tag[0] != u.pm) {
#pragma unroll
        for (int hh = 0; hh < 2; ++hh) { const int k = ln + 64 * hh; const unsigned row = u.pm * 256 + (k >> 6) * 128 + wr * 64 + ((k >> 4) & 3) * 16 + (k & 15);
            tab[k] = rstd4(*(const f32x4*)(ssq + row * 4u)); }
        if (ln == 0) tag[0] = u.pm;
    }
#pragma unroll
    for (int k = 0; k < 8; ++k) rs8[k] = tab[(k >> 2) * 64 + (k & 3) * 16 + fr];
}

struct EpiSwiglu {
    static constexpr bool PERM = true, AFTER_DRAIN = false;
    bf16* O; const float* ssq; LAS float* rtab;
    DI void operator()(const f32x4 (&acc)[2][2][4][2], const Unit& u, int wr, int wc, int fr, int fq) const {
        const unsigned row0 = u.pm * 256 + wr * 64 + fr; const unsigned col0 = u.pn * 128 + wc * 32 + 8 * fq;
        float rs8[8]; cached_rs8(rs8, ssq, rtab, u, wr, wc, fr, fq);
        unsigned row = row0;
#pragma unroll
        for (int ai = 0; ai < 2; ++ai) {
#pragma unroll
            for (int m = 0; m < 4; ++m) {
                const float rs = rs8[ai * 4 + m], rs2 = rs * rs, rsn = rs * -1.4426950409f;
                float h[8];
#pragma unroll
                for (int n = 0; n < 2; ++n)
#pragma unroll
                    for (int i = 0; i < 4; ++i) { const float a0 = acc[ai][0][m][n][i], a1 = acc[ai][1][m][n][i];
                        h[n * 4 + i] = (a0 * a1) * rs2 * __builtin_amdgcn_rcpf(1.f + __builtin_amdgcn_exp2f(a0 * rsn)); }
                *(u32x4*)(O + (row * (unsigned)DFF + col0)) = pack8(h);
                asm volatile("" : "+v"(row));
                row += 16;
            }
            row += 64;
        }
    }
};
struct EpiResid {
    static constexpr bool PERM = true, AFTER_DRAIN = false;
    bf16* xb; float* ssq; float alpha; LAS float* red;
    DI void operator()(const f32x4 (&acc)[2][2][4][2], const Unit& u, int wr, int wc, int fr, int fq) const {
        unsigned row = u.pm * 256 + wr * 64 + fr; const unsigned col0 = u.pn * 256 + wc * 32 + 8 * fq;
        u32x4 bv[2][4][2];
#pragma unroll
        for (int ai = 0; ai < 2; ++ai)
#pragma unroll
            for (int m = 0; m < 4; ++m)
#pragma unroll
                for (int bj = 0; bj < 2; ++bj) bv[ai][m][bj] = *(const u32x4*)(xb + ((row + 128 * ai + 16 * m) * (unsigned)DM + col0 + bj * 128));
#pragma unroll
        for (int ai = 0; ai < 2; ++ai) {
#pragma unroll
            for (int m = 0; m < 4; ++m) {
                float ss = 0.f; const unsigned off0 = row * (unsigned)DM + col0;
#pragma unroll
                for (int bj = 0; bj < 2; ++bj) {
                    float o[8]; unpack8(bv[ai][m][bj], o);
#pragma unroll
                    for (int n = 0; n < 2; ++n)
#pragma unroll
                        for (int i = 0; i < 4; ++i) { o[n * 4 + i] += acc[ai][bj][m][n][i] * alpha; ss += o[n * 4 + i] * o[n * 4 + i]; }
                    *(u32x4*)(xb + (off0 + bj * 128)) = pack8(o);
                }
                ss += __shfl_xor(ss, 16); ss += __shfl_xor(ss, 32);
                if (fq == 0) red[(ai * 128 + wr * 64 + m * 16 + fr) * 4 + wc] = ss;
                asm volatile("" : "+v"(row));
                row += 16;
            }
            asm volatile("" ::: "memory");
            row += 64;
        }
        asm volatile("s_waitcnt lgkmcnt(0)" ::: "memory"); __builtin_amdgcn_s_barrier(); asm volatile("" ::: "memory");
        const int t = (wr * 4 + wc) * 64 + fq * 16 + fr;
        if (t < 256) { const f32x4 p = *(const LAS f32x4*)(red + t * 4); ssq[(u.pm * 256 + t) * 4u + u.pn] = (p.x + p.y) + (p.z + p.w); }
    }
};
struct EpiProj {
    static constexpr bool PERM = true, AFTER_DRAIN = false;
    bf16* O; const float* ssq; LAS float* rtab;
    DI void operator()(const f32x4 (&acc)[2][2][4][2], const Unit& u, int wr, int wc, int fr, int fq) const {
        const unsigned row0 = u.pm * 256 + wr * 64 + fr; const unsigned col0 = u.pn * 256 + wc * 32 + 8 * fq;
        float rs8[8]; cached_rs8(rs8, ssq, rtab, u, wr, wc, fr, fq);
        unsigned row = row0;
#pragma unroll
        for (int ai = 0; ai < 2; ++ai) {
#pragma unroll
            for (int m = 0; m < 4; ++m) {
                const float rs = rs8[ai * 4 + m];
#pragma unroll
                for (int bj = 0; bj < 2; ++bj) {
                    float h[8];
#pragma unroll
                    for (int n = 0; n < 2; ++n)
#pragma unroll
                        for (int i = 0; i < 4; ++i) h[n * 4 + i] = acc[ai][bj][m][n][i] * rs;
                    *(u32x4*)(O + (row * (unsigned)NPROJ + col0 + bj * 128)) = pack8(h);
                }
                asm volatile("" : "+v"(row));
                row += 16;
            }
            row += 64;
        }
    }
};

DI const float* src_col(int kind, const float* g, const float* u, int n) {
    if (kind == 0) return g + n;
    if (kind == 1) { const int t = n >> 8, w = n & 255; return (w < 128) ? g + 128 * t + w : u + 128 * t + (w - 128); }
    if (n < 1536) return g + n;
    if (n < 2560) return g + n + 8;
    if (n < 2568) return g + 1536 + (n - 2560);
    return nullptr;
}
DI void transpose_item(int kind, const float* g, const float* u, int ldn, int K, int Np, const float* kscale, bf16* WT, LAS float* scr, int item, int lane) {
    const int nblk = Np / 32, kb = item / nblk, nb = item % nblk, k0 = 64 * kb, n0 = 32 * nb;
    const float* colp = src_col(kind, g, u, n0 + (lane & 31));
    float v[32];
    if (colp) {
        const float* p = colp + (size_t)(k0 + (lane >> 5)) * ldn;
#pragma unroll
        for (int i = 0; i < 32; ++i) v[i] = p[(size_t)(2 * i) * ldn];
    } else {
#pragma unroll
        for (int i = 0; i < 32; ++i) v[i] = 0.f;
    }
#pragma unroll
    for (int i = 0; i < 32; ++i) scr[(2 * i + (lane >> 5)) * 33 + (lane & 31)] = v[i];
    asm volatile("s_waitcnt lgkmcnt(0)" ::: "memory");
    const int c = lane & 7;
    float ks[8];
    if (kscale) { const f32x4 a = *(const f32x4*)(kscale + k0 + 8 * c), b2 = *(const f32x4*)(kscale + k0 + 8 * c + 4); ks[0] = a.x; ks[1] = a.y; ks[2] = a.z; ks[3] = a.w; ks[4] = b2.x; ks[5] = b2.y; ks[6] = b2.z; ks[7] = b2.w; }
    else {
#pragma unroll
        for (int i = 0; i < 8; ++i) ks[i] = 1.f;
    }
#pragma unroll
    for (int j = 0; j < 4; ++j) { const int n = (lane >> 3) + 8 * j; const LAS float* sp = scr + (8 * c) * 33 + n;
        u32x4 o; o.x = pk2(sp[0 * 33] * ks[0], sp[1 * 33] * ks[1]); o.y = pk2(sp[2 * 33] * ks[2], sp[3 * 33] * ks[3]); o.z = pk2(sp[4 * 33] * ks[4], sp[5 * 33] * ks[5]); o.w = pk2(sp[6 * 33] * ks[6], sp[7 * 33] * ks[7]);
        *(u32x4*)(WT + (size_t)(n0 + n) * K + k0 + 8 * c) = o; }
    asm volatile("s_waitcnt lgkmcnt(0)" ::: "memory");
}

DI void conv_load(u32x4 (&Rraw)[19], f32x4 (&Rw)[8], f32x4 (&Rb)[2], const bf16* __restrict__ proj, const float* __restrict__ cw, const float* __restrict__ cb, int pcol, size_t grow0, int c, int l0) {
    const int ch = pcol - PC_XBC;
    const bf16* p = proj + grow0 * NPROJ + pcol;
#pragma unroll
    for (int r = 0; r < 19; ++r) { const int l = l0 - 3 + r; Rraw[r] = (c == 0 && l < 0) ? (u32x4){0u, 0u, 0u, 0u} : *(const u32x4*)(p + (long)l * NPROJ); }
#pragma unroll
    for (int j = 0; j < 4; ++j) { Rw[2 * j] = *(const f32x4*)(cw + j * 1024 + ch); Rw[2 * j + 1] = *(const f32x4*)(cw + j * 1024 + ch + 4); }
    Rb[0] = *(const f32x4*)(cb + ch); Rb[1] = *(const f32x4*)(cb + ch + 4);
}
template <class F>
DI void conv_apply(const u32x4 (&Rraw)[19], const f32x4 (&Rw)[8], const f32x4 (&Rb)[2], int l0, F f) {
    float w[4][8], bias[8];
#pragma unroll
    for (int j = 0; j < 4; ++j)
#pragma unroll
        for (int i = 0; i < 4; ++i) { w[j][i] = Rw[2 * j][i]; w[j][4 + i] = Rw[2 * j + 1][i]; }
#pragma unroll
    for (int i = 0; i < 4; ++i) { bias[i] = Rb[0][i]; bias[4 + i] = Rb[1][i]; }
    float x0[8], x1[8], x2[8], x3[8];
    unpack8(Rraw[0], x0); unpack8(Rraw[1], x1); unpack8(Rraw[2], x2);
#pragma unroll
    for (int r = 0; r < 16; ++r) {
        unpack8(Rraw[r + 3], x3);
        float o[8];
#pragma unroll
        for (int i = 0; i < 8; ++i) { const float y = bias[i] + w[0][i] * x0[i] + w[1][i] * x1[i] + w[2][i] * x2[i] + w[3][i] * x3[i]; o[i] = silu_f(y); }
        f(l0 + r, o);
#pragma unroll
        for (int i = 0; i < 8; ++i) { x0[i] = x1[i]; x1[i] = x2[i]; x2[i] = x3[i]; }
        __builtin_amdgcn_sched_barrier(0);
    }
}

DI void ssd_dt_acs_wave(float x0, float x1, float negA, LAS float* s_dt, LAS float* s_acs, int lane) {
    const float d0 = (x0 > 20.f) ? x0 : log1pf(__expf(x0)), d1 = (x1 > 20.f) ? x1 : log1pf(__expf(x1));
    const float a0 = d0 * negA, a1 = d1 * negA;
    float sc = a0 + a1;
#pragma unroll
    for (int o = 1; o < 64; o <<= 1) { const float t = __shfl_up(sc, o); if (lane >= o) sc += t; }
    s_dt[2 * lane] = d0; s_dt[2 * lane + 1] = d1; s_acs[2 * lane] = sc - a1; s_acs[2 * lane + 1] = sc;
}

#define XB_TMO      128
#define XB_XCNT(j)  (256  + 64 * (j))
#define XB_XSUB(j)  (1280 + 64 * (j))
#define XB_XGEN(j)  (2304 + 64 * (j))
#define XB_TOP      3328
#define XB_TOPGEN   3392
#define XCD_BAR_WORDS 3456
#define XB_SPIN_CAP (1u << 18)

__device__ __forceinline__ unsigned xb_ld(unsigned* p)              { return __hip_atomic_load(p, __ATOMIC_RELAXED, __HIP_MEMORY_SCOPE_AGENT); }
__device__ __forceinline__ unsigned xb_add(unsigned* p, unsigned v) { return __hip_atomic_fetch_add(p, v, __ATOMIC_RELAXED, __HIP_MEMORY_SCOPE_AGENT); }
__device__ __forceinline__ unsigned xb_xcc_id() { return (unsigned)__builtin_amdgcn_s_getreg((3 << 11) | 20) & 0xFu; }
#define XB_SPIN(cond, bar) do { unsigned _sp = 0; while (cond) { __builtin_amdgcn_s_sleep(1); \
    if ((++_sp & 255u) == 0u) { if (xb_ld(&(bar)[XB_TMO])) break; if (_sp > XB_SPIN_CAP) { atomicAdd(&(bar)[XB_TMO], 1u); break; } } } } while (0)

struct XcdBarrier {
    unsigned* bar; unsigned x;
    volatile LAS unsigned* st;
};

__device__ __forceinline__ XcdBarrier xcd_barrier_post(unsigned* bar, volatile LAS unsigned* st) {
    XcdBarrier b; b.bar = bar; b.x = xb_xcc_id(); b.st = st;
    if (threadIdx.x == 0) (void)xb_add(&bar[XB_XCNT(b.x)], 1u);
    return b;
}
__device__ __forceinline__ void xcd_barrier_complete(unsigned* bar, unsigned x, unsigned& nloc, unsigned& nx) {
    const unsigned G = gridDim.x * gridDim.y * gridDim.z;
    unsigned sum, cnt, mine, sp = 0u;
    for (;;) {
        sum = 0u; cnt = 0u; mine = 0u;
#pragma unroll
        for (unsigned j = 0; j < 16; ++j) { const unsigned c = xb_ld(&bar[XB_XCNT(j)]); sum += c; cnt += (c > 0u) ? 1u : 0u; mine = (j == x) ? c : mine; }
        if (sum == G) break;
        __builtin_amdgcn_s_sleep(1);
        if ((++sp & 255u) == 0u) { if (xb_ld(&bar[XB_TMO])) break; if (sp > XB_SPIN_CAP) { atomicAdd(&bar[XB_TMO], 1u); break; } }
    }
    nloc = mine > 0u ? mine : 1u; nx = cnt > 0u ? cnt : 1u;
}

__device__ __forceinline__ void xcd_barrier(const XcdBarrier& b) {
    asm volatile("s_waitcnt vmcnt(0)" ::: "memory");
    __syncthreads();
    if (threadIdx.x == 0) {
        unsigned* bar = b.bar;
        __builtin_amdgcn_s_waitcnt(0);
        unsigned nloc = b.st[0], nx = b.st[1];
        if (nloc == 0u) { xcd_barrier_complete(bar, b.x, nloc, nx); b.st[0] = nloc; b.st[1] = nx; }
        const unsigned old = xb_add(&bar[XB_XSUB(b.x)], 1u);
        const unsigned gen = old / nloc;
        if (old + 1u == (gen + 1u) * nloc) {
            __builtin_amdgcn_fence(__ATOMIC_RELEASE, "agent");
            asm volatile("s_waitcnt vmcnt(0)" ::: "memory");
            const unsigned og = xb_add(&bar[XB_TOP], 1u);
            const unsigned tg = og / nx;
            if (og + 1u == (tg + 1u) * nx) xb_add(&bar[XB_TOPGEN], 1u);
            else XB_SPIN(xb_ld(&bar[XB_TOPGEN]) == tg, bar);
            __builtin_amdgcn_fence(__ATOMIC_ACQUIRE, "agent");
            xb_add(&bar[XB_XGEN(b.x)], 1u);
            asm volatile("s_waitcnt vmcnt(0)" ::: "memory");
        } else {
            XB_SPIN(xb_ld(&bar[XB_XGEN(b.x)]) == gen, bar);
            __builtin_amdgcn_fence(__ATOMIC_ACQUIRE, "agent");
            asm volatile("s_waitcnt vmcnt(0)" ::: "memory");
        }
    }
    __syncthreads();
}

struct Args { const float* in[27]; float* out; unsigned char* ws; };

__global__ void __launch_bounds__(512, 2) fwd_megakernel(Args args) {
    extern __shared__ __attribute__((aligned(16))) unsigned char lds_raw[];
    LAS unsigned char* lds = (LAS unsigned char*)lds_raw;
    cg::grid_group grid = cg::this_grid();
    if (args.ws == nullptr) grid.sync();
    volatile LAS unsigned* bst = (volatile LAS unsigned*)(lds + 147440);
    if (threadIdx.x < 4) bst[threadIdx.x] = 0u;
    __syncthreads();
    (void)xcd_barrier_post((unsigned*)(args.ws + WS_BAR), bst);
#define GRID_SYNC() do { XcdBarrier b_; b_.bar = (unsigned*)(args.ws + WS_BAR); b_.x = xb_xcc_id(); b_.st = (volatile LAS unsigned*)(lds + 147440); xcd_barrier(b_); } while (0)
    const int wave = __builtin_amdgcn_readfirstlane((int)threadIdx.x >> 6);
    const int G = gridDim.x, bid = blockIdx.x;
    const int gw = bid * 8 + wave, NGW = G * 8;
    unsigned char* ws = args.ws;
    float* ssq = (float*)(ws + WS_SSQ);     float* mss_g = (float*)(ws + WS_MSSQ);   float* mss_a = mss_g + (size_t)2 * MTOK * 4;   float* dtraw = (float*)(ws + WS_DTRAW); float* CD = (float*)(ws + WS_CD);
    bf16* sguW = (bf16*)(ws + WS_SGUW);
    bf16* xb = (bf16*)(ws + WS_XB); float* ST = args.out;     bf16* actb = (bf16*)(ws + WS_ACT); bf16* Yg = (bf16*)(ws + WS_YG); bf16* ycat = (bf16*)(ws + WS_YCAT);
    bf16* PV = (bf16*)(ws + WS_PV); bf16* proj = (bf16*)(ws + WS_PROJ);

#if PH & 1
#ifndef PROREP
#define PROREP 1
#endif
#ifndef SYNCREP
#define SYNCREP 0
#endif
    for (int rep_ = 0; rep_ < SYNCREP; ++rep_) GRID_SYNC();
    for (int rep_ = 0; rep_ < PROREP; ++rep_) {
        PHASE_IDS();
        LAS float* scr = (LAS float*)(lds + wave * 16384);
        for (int mi = 0; mi < 12; ++mi) {
            const int l = mi / 6, t = mi % 6;
            const float* g; const float* u = nullptr; const float* ks = nullptr; int kind = 0, ldn, K, Np; bf16* WT = (bf16*)(ws + WS_W + (size_t)l * WL_SIZE);
            if (t == 0)      { g = args.in[2] + (size_t)l * DM * DFF; u = args.in[3] + (size_t)l * DM * DFF; ks = args.in[1] + l * DM; kind = 1; ldn = DFF; K = DM; Np = NGU; WT += WL_GU1 / 2; }
            else if (t == 1) { g = args.in[4] + (size_t)l * DFF * DM; ldn = DM; K = DFF; Np = DM; WT += WL_D1 / 2; }
            else if (t == 2) { g = args.in[6] + (size_t)l * DM * DINP; ks = args.in[5] + l * DM; kind = 2; ldn = DINP; K = DM; Np = NPROJ; WT += WL_IN / 2; }
            else if (t == 3) { g = args.in[21] + (size_t)l * DM * DM; ldn = DM; K = DM; Np = DM; WT += WL_OUT / 2; }
            else if (t == 4) { g = args.in[23] + (size_t)l * DM * DFF; u = args.in[24] + (size_t)l * DM * DFF; ks = args.in[22] + l * DM; kind = 1; ldn = DFF; K = DM; Np = NGU; WT += WL_GU2 / 2; }
            else             { g = args.in[25] + (size_t)l * DFF * DM; ldn = DM; K = DFF; Np = DM; WT += WL_D2 / 2; }
            const int nitems = (K / 64) * (Np / 32);
            for (int it = gw; it < nitems; it += NGW) transpose_item(kind, g, u, ldn, K, Np, ks, WT, scr, it, lane);
        }
        for (int i = bid * 512 + tid; i < DEPTH * 4 * 128 * 128; i += G * 512) { const int t = (i >> 7) & 127, s = i & 127; sguW[i] = f2bf(s <= t ? args.in[18][i] : 0.f); }
        const float* x = args.in[0];
        for (int m0 = gw; m0 < MTOK; m0 += 4 * NGW) {
            f32x4 v[4][4];
#pragma unroll
            for (int r = 0; r < 4; ++r) { const int m = min(m0 + r * NGW, MTOK - 1); const f32x4* xr = (const f32x4*)(x + (size_t)m * DM) + 2 * lane;
#pragma unroll
                for (int j = 0; j < 2; ++j) { v[r][2 * j] = xr[128 * j]; v[r][2 * j + 1] = xr[128 * j + 1]; } }
#pragma unroll
            for (int r = 0; r < 4; ++r) { const int m = m0 + r * NGW; if (m < MTOK) {
                float sq = 0.f; u32x4* o16 = (u32x4*)(xb + (size_t)m * DM) + lane;
#pragma unroll
                for (int j = 0; j < 2; ++j) { const f32x4 t = v[r][2 * j], t2 = v[r][2 * j + 1];
                    sq += ((t.x * t.x + t.y * t.y) + (t.z * t.z + t.w * t.w)) + ((t2.x * t2.x + t2.y * t2.y) + (t2.z * t2.z + t2.w * t2.w));
                    u32x4 w; w.x = pk2(t.x, t.y); w.y = pk2(t.z, t.w); w.z = pk2(t2.x, t2.y); w.w = pk2(t2.z, t2.w); o16[64 * j] = w; }
                sq = wave_sum(sq);
                if (lane == 0) *(f32x4*)(ssq + (size_t)m * 4) = (f32x4){sq, 0.f, 0.f, 0.f}; } }
        }
    }
#endif
    GRID_SYNC();

    for (int layer = 0; layer < DEPTH; ++layer) {
        const bf16* Wl = (const bf16*)(ws + WS_W + (size_t)layer * WL_SIZE);
        for (int half = 0; half < 2; ++half) {
#if PH & 2
#ifndef UPREP
#define UPREP 1
#endif
            for (int rep_ = 0; rep_ < UPREP; ++rep_) {
                pg8::Gemm g{xb, Wl + (half ? WL_GU2 : WL_GU1) / 2, MTOK, NGU, DM}; pg8::StaticOrder S; S.init(MTOK, NGU, G, bid);
                if (lane0_()) *(LAS int*)((LAS float*)(lds + 135168) + wave * 132 + 128) = -1;
                EpiSwiglu E{actb, ssq + (size_t)(3 * layer + 2 * half) * MTOK * 4, (LAS float*)(lds + 135168)};
                pg8::gemm_phase<EpiSwiglu, pg8::StaticOrder, true, true>(lds, g, S, E);
            }
            GRID_SYNC();
            {
                pg8::Gemm g{actb, Wl + (half ? WL_D2 : WL_D1) / 2, MTOK, DM, DFF}; pg8::StaticOrder S; S.init(MTOK, DM, G, bid);
                EpiResid E{xb, ssq + (size_t)(3 * layer + 2 * half + 1) * MTOK * 4, 0.5f, (LAS float*)(lds + 131072)};
                pg8::gemm_phase<EpiResid, pg8::StaticOrder, true, true>(lds, g, S, E);
            }
            GRID_SYNC();
            if (half == 1) break;

#endif
#if PH & 4
            {
                pg8::Gemm g{xb, Wl + WL_IN / 2, MTOK, 2560, DM}; pg8::StaticOrder S; S.init(MTOK, 2560, G, bid);
                if (lane0_()) *(LAS int*)((LAS float*)(lds + 135168) + wave * 132 + 128) = -1;
                EpiProj E{proj, ssq + (size_t)(3 * layer + 1) * MTOK * 4, (LAS float*)(lds + 135168)};
                pg8::gemm_phase<EpiProj, pg8::StaticOrder, true, true>(lds, g, S, E);
            }
            {
                PHASE_IDS();
                const float* ssq_in = ssq + (size_t)(3 * layer + 1) * MTOK * 4;
                const bf16* wdt = Wl + WL_IN / 2 + (size_t)(2560 + r16) * DM + q4 * 8;
                for (int rb = gw; rb < MTOK / 16; rb += NGW) {
                    const bf16* xa = xb + (size_t)(rb * 16 + r16) * DM + q4 * 8;
                    f32x4 acc = (f32x4){0.f, 0.f, 0.f, 0.f};
#pragma unroll 16
                    for (int ks = 0; ks < 32; ++ks) acc = mfma16(*(const bf16x8*)(xa + ks * 32), *(const bf16x8*)(wdt + ks * 32), acc);
                    if (r16 < 8) {
#pragma unroll
                        for (int j = 0; j < 4; ++j) { const unsigned row = rb * 16 + q4 * 4 + j; dtraw[row * 8u + r16] = acc[j] * row_rstd(ssq_in, row); }
                    }
                }
            }
            GRID_SYNC();

            const float* conv_w = args.in[7] + layer * 4 * 1024; const float* conv_b = args.in[8] + layer * 1024;
#endif
#ifndef MIXREP
#define MIXREP 1
#endif
#ifndef REPMASK
#define REPMASK 0
#endif
            for (int rep_ = 0; rep_ < MIXREP; ++rep_) {
#if PH & 8
            for (int rp_ = 0; rp_ < ((REPMASK & 8) ? 2 : 1); ++rp_)
            for (int unit = bid; unit < BATCH * NCH * 2; unit += G) {
                PHASE_IDS();
                const int g2 = unit & 1, c = (unit >> 1) & 31, b = unit >> 6;
                const size_t grow0 = (size_t)b * SEQ + c * 128;
                LAS bf16* xT = (LAS bf16*)lds;
                LAS bf16* BTs = (LAS bf16*)(lds + 69632);
                LAS float* s_dt = (LAS float*)(lds + 104448); LAS float* s_acs = s_dt + 512;
                u32x4 Rraw[19]; f32x4 Rw[8]; f32x4 Rb[2]; float dx[4] = {0.f, 0.f, 0.f, 0.f};
#pragma unroll
                for (int i = 0; i < 19; ++i) Rraw[i] = (u32x4){0u, 0u, 0u, 0u};
#pragma unroll
                for (int i = 0; i < 8; ++i) Rw[i] = (f32x4){0.f, 0.f, 0.f, 0.f};
                Rb[0] = (f32x4){0.f, 0.f, 0.f, 0.f}; Rb[1] = (f32x4){0.f, 0.f, 0.f, 0.f};
                const int cgi = tid >> 3, l0 = (tid & 7) * 16;
                if (wave < 4) conv_load(Rraw, Rw, Rb, proj, conv_w, conv_b, PC_XBC + g2 * 256 + cgi * 8, grow0, c, l0);
                else if (wave < 6) conv_load(Rraw, Rw, Rb, proj, conv_w, conv_b, PC_XBC + 512 + g2 * 128 + (cgi - 32) * 8, grow0, c, l0);
                else {
#pragma unroll
                    for (int k = 0; k < 2; ++k) { const int h = g2 * 4 + (wave - 6) * 2 + k; const float dtb = args.in[9][layer * 8 + h];
                        dx[2 * k] = dtraw[(grow0 + 2 * lane) * 8 + h] + dtb; dx[2 * k + 1] = dtraw[(grow0 + 2 * lane + 1) * 8 + h] + dtb; }
#pragma unroll
                    for (int k = 0; k < 2; ++k) { const int hh = (wave - 6) * 2 + k; ssd_dt_acs_wave(dx[2 * k], dx[2 * k + 1], -__expf(args.in[10][layer * 8 + g2 * 4 + hh]), s_dt + hh * 128, s_acs + hh * 128, lane); }
                }
                __syncthreads();
                if (wave < 4) {
                    const int hh = cgi >> 3, pl = (cgi & 7) * 8; const float acs_end = s_acs[hh * 128 + 127];
                    LAS bf16* dst = xT + hh * (64 * 136);
                    conv_apply(Rraw, Rw, Rb, l0, [&](int l, const float (&o)[8]) {
                        const float sc = s_dt[hh * 128 + l] * __expf(acs_end - s_acs[hh * 128 + l]);
#pragma unroll
                        for (int i = 0; i < 8; ++i) dst[(pl + i) * 136 + l] = f2bf(o[i] * sc); });
                } else if (wave < 6) {
                    const int nl = (cgi - 32) * 8;
                    conv_apply(Rraw, Rw, Rb, l0, [&](int l, const float (&o)[8]) {
#pragma unroll
                        for (int i = 0; i < 8; ++i) BTs[(nl + i) * 136 + l] = f2bf(o[i]); });
                }
                __syncthreads();
                {
                    bf16x8 bfr[4];
#pragma unroll
                    for (int ks = 0; ks < 4; ++ks) bfr[ks] = lds_frag(BTs, 16 * wave + r16, 136, ks * 32 + q4 * 8);
#pragma unroll
                    for (int hh = 0; hh < 4; ++hh) {
                        f32x4 acc[4];
#pragma unroll
                        for (int pt = 0; pt < 4; ++pt) acc[pt] = (f32x4){0.f, 0.f, 0.f, 0.f};
#pragma unroll
                        for (int ks = 0; ks < 4; ++ks)
#pragma unroll
                            for (int pt = 0; pt < 4; ++pt) acc[pt] = mfma16(bfr[ks], lds_frag(xT + hh * (64 * 136), 16 * pt + r16, 136, ks * 32 + q4 * 8), acc[pt]);
                        const int unit8 = ((b * NCH + c) * 8) + g2 * 4 + hh;
                        float* st = ST + (size_t)unit8 * 8192;
#pragma unroll
                        for (int pt = 0; pt < 4; ++pt) *(f32x4*)(st + (16 * pt + r16) * 128 + 16 * wave + q4 * 4) = acc[pt];
                    }
                }
                if (tid < 4) CD[((b * NCH + c) * 2 + g2) * 32 + tid] = __expf(s_acs[tid * 128 + 127]);
                __syncthreads();
            }
#endif
#if PH & 16
            for (int rp_ = 0; rp_ < ((REPMASK & 16) ? 2 : 1); ++rp_)
            for (int unit = bid; unit < BATCH * NCH; unit += G) {
                PHASE_IDS();
                const int nb = unit & 31, b = unit >> 5;
                const size_t grow0 = (size_t)b * SEQ + nb * 128;
                LAS bf16* Ks = (LAS bf16*)lds; LAS bf16* VT = (LAS bf16*)(lds + 36864); LAS bf16* Ps = (LAS bf16*)(lds + 72704) + wave * (16 * 168);
                LAS float* s_bias = (LAS float*)(lds + 115712);
                s_bias[tid] = args.in[14][T5_BUCKET[tid & 127] * 4 + (tid >> 7)];
                for (int it = tid; it < 64 * 24; it += 512) { const int d = it / 24, j = 256 + it % 24; VT[d * 280 + j] = 0; }
                f32x4 og[4][4]; float ssr[4] = {0.f, 0.f, 0.f, 0.f};
#pragma unroll
                for (int kvh = 0; kvh < 2; ++kvh) {
                    if (kvh) __syncthreads();
                    {
                        u32x4 kq[4], vq[4];
#pragma unroll
                        for (int k = 0; k < 4; ++k) {
                            const int it = tid + 512 * k, j = it >> 3, d8 = (it & 7) * 8;
                            kq[k] = (u32x4){0u, 0u, 0u, 0u}; vq[k] = (u32x4){0u, 0u, 0u, 0u};
                            if (nb > 0 || j >= 128) { const bf16* src = proj + (grow0 + j - 128) * NPROJ + kvh * 64 + d8; kq[k] = *(const u32x4*)(src + PC_K); vq[k] = *(const u32x4*)(src + PC_V); }
                        }
#pragma unroll
                        for (int k = 0; k < 4; ++k) {
                            const int it = tid + 512 * k, j = it >> 3, d8 = (it & 7) * 8;
                            *(LAS u32x4*)(Ks + j * 72 + d8) = kq[k];
                            const unsigned vw[4] = {vq[k].x, vq[k].y, vq[k].z, vq[k].w};
#pragma unroll
                            for (int i = 0; i < 4; ++i) { VT[(d8 + 2 * i) * 280 + j] = (bf16)(vw[i] & 0xffffu); VT[(d8 + 2 * i + 1) * 280 + j] = (bf16)(vw[i] >> 16); }
                        }
                    }
                    __syncthreads();
#pragma unroll
                    for (int g = 0; g < 2; ++g) {
                        const int hq = kvh * 2 + g;
                        const float sink = args.in[13][layer * 4 + hq];
                        const bf16* qp = proj + (grow0 + 16 * wave + r16) * NPROJ + PC_Q + hq * 64 + q4 * 8;
                        const bf16x8 aq0 = *(const bf16x8*)qp, aq1 = *(const bf16x8*)(qp + 32);
                        f32x4 sc[9];
#pragma unroll
                        for (int kk = 0; kk < 9; ++kk) {
                            const int krow = 16 * (wave + kk) + r16;
                            f32x4 a = (f32x4){0.f, 0.f, 0.f, 0.f};
                            a = mfma16(aq0, lds_frag(Ks, krow, 72, q4 * 8), a);
                            a = mfma16(aq1, lds_frag(Ks, krow, 72, 32 + q4 * 8), a);
                            sc[kk] = a;
                        }
                        float sm[4];
#pragma unroll
                        for (int j = 0; j < 4; ++j) {
                            const int i = 16 * wave + q4 * 4 + j; float m = -INFINITY;
#pragma unroll
                            for (int kk = 0; kk < 9; ++kk) {
                                const int jk = 16 * (wave + kk) + r16, dist = i - jk + 128;
                                const bool ok = (dist >= 0) && (dist < 128) && (nb > 0 || jk >= 128);
                                const float sv = ok ? sc[kk][j] * 0.125f + s_bias[hq * 128 + (dist & 127)] : -INFINITY;
                                sc[kk][j] = sv; m = fmaxf(m, sv);
                            }
                            m = fmaxf(max16(m), sink);
                            float su = 0.f;
#pragma unroll
                            for (int kk = 0; kk < 9; ++kk) { const float p = __expf(sc[kk][j] - m); sc[kk][j] = p; su += p; }
                            sm[j] = sum16(su) + __expf(sink - m);
                        }
#pragma unroll
                        for (int kk = 0; kk < 9; ++kk)
#pragma unroll
                            for (int j = 0; j < 4; ++j) Ps[(q4 * 4 + j) * 168 + kk * 16 + r16] = f2bf(sc[kk][j]);
                        *(LAS u32x2*)(Ps + (lane >> 2) * 168 + 144 + (lane & 3) * 4) = (u32x2){0u, 0u};
                        f32x4 oa[4];
#pragma unroll
                        for (int dt = 0; dt < 4; ++dt) oa[dt] = (f32x4){0.f, 0.f, 0.f, 0.f};
#pragma unroll
                        for (int ks = 0; ks < 5; ++ks) {
                            const bf16x8 pa = lds_frag(Ps, r16, 168, ks * 32 + q4 * 8);
#pragma unroll
                            for (int dt = 0; dt < 4; ++dt) oa[dt] = mfma16(pa, lds_frag(VT, 16 * dt + r16, 280, 16 * wave + ks * 32 + q4 * 8), oa[dt]);
                        }
#pragma unroll
                        for (int j = 0; j < 4; ++j) { const float inv = 1.f / sm[j];
#pragma unroll
                            for (int dt = 0; dt < 4; ++dt) { const float o = oa[dt][j] * inv; ssr[j] += o * o; og[hq][dt][j] = o; } }
                    }
                }
#pragma unroll
                for (int hq = 0; hq < 4; ++hq) {
#pragma unroll
                    for (int j = 0; j < 4; ++j) {
                        const size_t row = grow0 + 16 * wave + q4 * 4 + j; float ss = 0.f;
#pragma unroll
                        for (int dt = 0; dt < 4; ++dt) { const float o = og[hq][dt][j]; ss += o * o; Yg[row * DM + 512 + hq * 64 + 16 * dt + r16] = f2bf(o); }
                        ss = sum16(ss);
                        if (r16 == 0) mss_a[(size_t)hq * MTOK + row] = ss;
                    }
                }
                __syncthreads();
            }
#endif
#if PH & 32
            for (int rp_ = 0; rp_ < ((REPMASK & 32) ? 2 : 1); ++rp_)
            for (int unit = bid; unit < BATCH * NCH; unit += G) {
                PHASE_IDS();
                const int c = unit & 31, b = unit >> 5;
                const size_t grow0 = (size_t)b * SEQ + c * 128;
                LAS bf16* vnT = (LAS bf16*)lds;
                LAS bf16* Us = (LAS bf16*)(lds + 69632);
                const int l = tid >> 2, sub = tid & 3;
                u32x4 gvr[8], ur[8]; bf16x8 wa[4][4];
                {
                    const bf16* src = proj + (grow0 + l) * NPROJ + PC_GV + sub * 64;
#pragma unroll
                    for (int k = 0; k < 8; ++k) gvr[k] = *(const u32x4*)(src + 8 * k);
#pragma unroll
                    for (int k = 0; k < 8; ++k) { const int it = tid + 512 * k, t = it >> 5, c8 = (it & 31) * 8; ur[k] = *(const u32x4*)(proj + (grow0 + t) * NPROJ + PC_U + c8); }
                }
                {
                    float v[64]; float sm = 0.f;
#pragma unroll
                    for (int k = 0; k < 8; ++k) { float t8[8]; unpack8(gvr[k], t8);
#pragma unroll
                        for (int i = 0; i < 8; ++i) { v[8 * k + i] = gelu_f(t8[i]); sm += v[8 * k + i]; } }
                    sm += __shfl_xor(sm, 1); sm += __shfl_xor(sm, 2);
                    const float mean = sm * (1.f / 256.f); float qv = 0.f;
#pragma unroll
                    for (int i = 0; i < 64; ++i) { const float d = v[i] - mean; qv += d * d; }
                    qv += __shfl_xor(qv, 1); qv += __shfl_xor(qv, 2);
                    const float rstd = rsqrtf(qv * (1.f / 256.f) + EPS);
                    const float* lw = args.in[16] + layer * 256 + sub * 64; const float* lb = args.in[17] + layer * 256 + sub * 64;
                    LAS bf16* dst = vnT + sub * (64 * 136) + l;
#pragma unroll
                    for (int i = 0; i < 64; ++i) dst[i * 136] = f2bf((v[i] - mean) * rstd * lw[i] + lb[i]);
                }
#pragma unroll
                for (int k = 0; k < 8; ++k) { const int it = tid + 512 * k, t = it >> 5, c8 = (it & 31) * 8; *(LAS u32x4*)(Us + t * 264 + c8) = ur[k]; }
#pragma unroll
                for (int gi = 0; gi < 4; ++gi)
#pragma unroll
                    for (int ks = 0; ks < 4; ++ks) wa[gi][ks] = *(const bf16x8*)(sguW + (size_t)(layer * 4 + gi) * 16384 + (16 * wave + r16) * 128 + ks * 32 + q4 * 8);
                __syncthreads();
                {
                    f32x4 og[4][4]; float ss[4] = {0.f, 0.f, 0.f, 0.f};
#pragma unroll
                    for (int gi = 0; gi < 4; ++gi) {
                        f32x4 acc[4];
#pragma unroll
                        for (int dt = 0; dt < 4; ++dt) acc[dt] = (f32x4){0.f, 0.f, 0.f, 0.f};
#pragma unroll
                        for (int ks = 0; ks < 4; ++ks) {
                            if (2 * ks <= wave) {
#pragma unroll
                                for (int dt = 0; dt < 4; ++dt) acc[dt] = mfma16(wa[gi][ks], lds_frag(vnT + gi * (64 * 136), 16 * dt + r16, 136, ks * 32 + q4 * 8), acc[dt]);
                            }
                        }
#pragma unroll
                        for (int j = 0; j < 4; ++j) {
                            const int t = 16 * wave + q4 * 4 + j; const float bs = args.in[19][(layer * 4 + gi) * 128 + t];
#pragma unroll
                            for (int dt = 0; dt < 4; ++dt) {
                                const float uu = gelu_f(bf2f(Us[t * 264 + gi * 64 + 16 * dt + r16]));
                                const float o = uu * (acc[dt][j] + bs); ss[j] += o * o; og[gi][dt][j] = o;
                            }
                        }
                    }
                    float rs[4];
#pragma unroll
                    for (int j = 0; j < 4; ++j) rs[j] = rsqrtf(sum16(ss[j]) * (1.f / 256.f) + EPS);
#pragma unroll
                    for (int gi = 0; gi < 4; ++gi)
#pragma unroll
                        for (int dt = 0; dt < 4; ++dt) {
                            const int col = gi * 64 + 16 * dt + r16; const float nw = args.in[20][layer * 256 + col];
#pragma unroll
                            for (int j = 0; j < 4; ++j) ycat[(grow0 + 16 * wave + q4 * 4 + j) * DM + 768 + col] = f2bf(og[gi][dt][j] * rs[j] * nw);
                        }
                }
                __syncthreads();
            }
            GRID_SYNC();
#endif
#if PH & 64
            for (int rp_ = 0; rp_ < ((REPMASK & 64) ? 2 : 1); ++rp_)
            { PHASE_IDS();
            for (int e = bid * 512 + tid; e < BATCH * 8 * 2048; e += G * 512) {
                const int i4 = e & 2047, h = (e >> 11) & 7, b = e >> 14;
                f32x4 carry = (f32x4){0.f, 0.f, 0.f, 0.f};
#pragma unroll 8
                for (int c = 0; c < NCH; ++c) {
                    const int unit = (b * NCH + c) * 8 + h;
                    const f32x4 st = *(const f32x4*)(ST + (size_t)unit * 8192 + i4 * 4); const float dec = CD[((b * NCH + c) * 2 + (h >> 2)) * 32 + (h & 3)];
                    u32x2 w; w.x = pk2(carry.x, carry.y); w.y = pk2(carry.z, carry.w); *(u32x2*)(PV + (size_t)unit * 8192 + i4 * 4) = w;
                    carry = carry * dec + st;
                }
            } }
            GRID_SYNC();
#endif
#if PH & 128
            for (int rp_ = 0; rp_ < ((REPMASK & 128) ? 2 : 1); ++rp_)
            for (int unit = bid; unit < BATCH * NCH * 2; unit += G) {
                PHASE_IDS();
                const int g2 = unit & 1, c = (unit >> 1) & 31, b = unit >> 6;
                const size_t grow0 = (size_t)b * SEQ + c * 128;
                LAS bf16* Cs = (LAS bf16*)lds; LAS bf16* Bs = (LAS bf16*)(lds + 34816); LAS bf16* Ms = Bs;
                LAS bf16* xT = (LAS bf16*)(lds + 69632);
                LAS float* s_dt = (LAS float*)(lds + 139264); LAS float* s_acs = s_dt + 512;
                u32x4 Rraw[19]; f32x4 Rw[8]; f32x4 Rb[2]; float dx0 = 0.f, dx1 = 0.f;
                const int cgi = tid >> 3, l0 = (tid & 7) * 16;
                if (wave < 4) {
                    conv_load(Rraw, Rw, Rb, proj, conv_w, conv_b, PC_XBC + g2 * 256 + cgi * 8, grow0, c, l0);
                    const int h = g2 * 4 + wave; const float dtb = args.in[9][layer * 8 + h];
                    dx0 = dtraw[(grow0 + 2 * lane) * 8 + h] + dtb; dx1 = dtraw[(grow0 + 2 * lane + 1) * 8 + h] + dtb;
                } else if (wave < 6) conv_load(Rraw, Rw, Rb, proj, conv_w, conv_b, PC_XBC + 512 + g2 * 128 + (cgi - 32) * 8, grow0, c, l0);
                else conv_load(Rraw, Rw, Rb, proj, conv_w, conv_b, PC_XBC + 768 + g2 * 128 + (cgi - 48) * 8, grow0, c, l0);
                if (wave < 4) {
                    const int hh = cgi >> 3, pl = (cgi & 7) * 8;
                    LAS bf16* dst = xT + hh * (64 * 136);
                    conv_apply(Rraw, Rw, Rb, l0, [&](int l, const float (&o)[8]) {
#pragma unroll
                        for (int i = 0; i < 8; ++i) dst[(pl + i) * 136 + l] = f2bf(o[i]); });
                    ssd_dt_acs_wave(dx0, dx1, -__expf(args.in[10][layer * 8 + g2 * 4 + wave]), s_dt + wave * 128, s_acs + wave * 128, lane);
                } else if (wave < 6) {
                    const int nl = (cgi - 32) * 8;
                    conv_apply(Rraw, Rw, Rb, l0, [&](int l, const float (&o)[8]) { *(LAS u32x4*)(Bs + l * 136 + nl) = pack8(o); });
                } else {
                    const int nl = (cgi - 48) * 8;
                    conv_apply(Rraw, Rw, Rb, l0, [&](int l, const float (&o)[8]) { *(LAS u32x4*)(Cs + l * 136 + nl) = pack8(o); });
                }
                __syncthreads();
                {
                    const int lrow = 16 * wave + r16;
                    bf16x8 ca[4];
#pragma unroll
                    for (int ks = 0; ks < 4; ++ks) ca[ks] = lds_frag(Cs, lrow, 136, ks * 32 + q4 * 8);
                    f32x4 cbr[8];
#pragma unroll
                    for (int st = 0; st < 8; ++st) {
                        cbr[st] = (f32x4){0.f, 0.f, 0.f, 0.f};
                        if (st <= wave) {
#pragma unroll
                            for (int ks = 0; ks < 4; ++ks) cbr[st] = mfma16(ca[ks], lds_frag(Bs, 16 * st + r16, 136, ks * 32 + q4 * 8), cbr[st]);
                        }
                    }
                    __syncthreads();
#pragma unroll 1
                    for (int hh = 0; hh < 4; ++hh) {
                        const int h = g2 * 4 + hh; const int unit8 = ((b * NCH + c) * 8) + h;
                        bf16x8 pvf[4][4];
                        {
                            const bf16* pv = PV + (size_t)unit8 * 8192;
#pragma unroll
                            for (int ks = 0; ks < 4; ++ks)
#pragma unroll
                                for (int pt = 0; pt < 4; ++pt) pvf[ks][pt] = *(const bf16x8*)(pv + (16 * pt + r16) * 128 + ks * 32 + q4 * 8);
                        }
                        bf16 zr[4][4];
#pragma unroll
                        for (int j = 0; j < 4; ++j)
#pragma unroll
                            for (int pt = 0; pt < 4; ++pt) zr[j][pt] = proj[(grow0 + 16 * wave + q4 * 4 + j) * NPROJ + PC_Z + h * 64 + 16 * pt + r16];
                        const LAS float* hdt = s_dt + hh * 128; const LAS float* hacs = s_acs + hh * 128;
                        float acl[4];
#pragma unroll
                        for (int j = 0; j < 4; ++j) acl[j] = hacs[16 * wave + q4 * 4 + j];
#pragma unroll
                        for (int st = 0; st < 8; ++st) {
                            if (st <= (wave | 1)) {
                                const int sI = 16 * st + r16; const float acss = hacs[sI], dts = hdt[sI];
#pragma unroll
                                for (int j = 0; j < 4; ++j) { const int l = 16 * wave + q4 * 4 + j; const float mv = (sI <= l) ? cbr[st][j] * __expf(fminf(acl[j] - acss, 0.f)) * dts : 0.f; Ms[l * 136 + sI] = f2bf(mv); }
                            }
                        }
                        f32x4 yo[4], yd[4];
#pragma unroll
                        for (int pt = 0; pt < 4; ++pt) { yo[pt] = (f32x4){0.f, 0.f, 0.f, 0.f}; yd[pt] = (f32x4){0.f, 0.f, 0.f, 0.f}; }
                        const LAS bf16* xh = xT + hh * (64 * 136);
#pragma unroll
                        for (int ks = 0; ks < 4; ++ks) {
                            if (2 * ks <= wave) {
                                const bf16x8 ma = lds_frag(Ms, lrow, 136, ks * 32 + q4 * 8);
#pragma unroll
                                for (int pt = 0; pt < 4; ++pt) yd[pt] = mfma16(ma, lds_frag(xh, 16 * pt + r16, 136, ks * 32 + q4 * 8), yd[pt]);
                            }
                        }
#pragma unroll
                        for (int ks = 0; ks < 4; ++ks)
#pragma unroll
                            for (int pt = 0; pt < 4; ++pt) yo[pt] = mfma16(ca[ks], pvf[ks][pt], yo[pt]);
                        const float Dh = args.in[11][layer * 8 + h];
#pragma unroll
                        for (int j = 0; j < 4; ++j) {
                            const int l = 16 * wave + q4 * 4 + j; const size_t row = grow0 + l; const float ea = __expf(acl[j]); float ss = 0.f;
#pragma unroll
                            for (int pt = 0; pt < 4; ++pt) {
                                const int p = 16 * pt + r16;
                                const float y = yd[pt][j] + ea * yo[pt][j] + Dh * bf2f(xh[p * 136 + l]);
                                const float o = y * silu_f(bf2f(zr[j][pt])); ss += o * o; Yg[row * DM + h * 64 + p] = f2bf(o);
                            }
                            ss = sum16(ss);
                            if (r16 == 0) mss_g[((size_t)g2 * MTOK + row) * 4 + hh] = ss;
                        }
                    }
                }
                __syncthreads();
            }
            GRID_SYNC();
#endif
#if PH & 256
            for (int rp_ = 0; rp_ < ((REPMASK & 256) ? 2 : 1); ++rp_)
            for (int m0 = gw; m0 < MTOK; m0 += 4 * NGW) {
                PHASE_IDS();
                f32x4 sv[4][3]; u32x4 yv[4][2];
                const int colA = lane * 8, colB = 512 + lane * 8;
#pragma unroll
                for (int r = 0; r < 4; ++r) { const int m = min(m0 + r * NGW, MTOK - 1);
                    sv[r][0] = *(const f32x4*)(mss_g + (size_t)m * 4); sv[r][1] = *(const f32x4*)(mss_g + ((size_t)MTOK + m) * 4); sv[r][2] = (f32x4){mss_a[m], mss_a[(size_t)MTOK + m], mss_a[(size_t)2 * MTOK + m], mss_a[(size_t)3 * MTOK + m]};
                    yv[r][0] = *(const u32x4*)(Yg + (size_t)m * DM + colA); yv[r][1] = *(const u32x4*)(Yg + (size_t)m * DM + 512 + (lane & 31) * 8); }
                float nwA[8], nwB[8];
                { const float* p = args.in[12] + layer * 512 + colA;
#pragma unroll
                  for (int i = 0; i < 8; ++i) nwA[i] = p[i];
                  const float* q = args.in[15] + layer * 256 + (lane & 31) * 8;
#pragma unroll
                  for (int i = 0; i < 8; ++i) nwB[i] = q[i]; }
#pragma unroll
                for (int r = 0; r < 4; ++r) { const int m = m0 + r * NGW; if (m < MTOK) {
                    const f32x4 s0 = sv[r][0], s1 = sv[r][1], s2 = sv[r][2];
                    const float r_ssd = rsqrtf((((s0.x + s0.y) + (s0.z + s0.w)) + ((s1.x + s1.y) + (s1.z + s1.w))) * (1.f / 512.f) + EPS);
                    const float r_att = rsqrtf(((s2.x + s2.y) + (s2.z + s2.w)) * (1.f / 256.f) + EPS);
                    float v[8]; unpack8(yv[r][0], v);
#pragma unroll
                    for (int i = 0; i < 8; ++i) v[i] = v[i] * r_ssd * nwA[i];
                    *(u32x4*)(ycat + (size_t)m * DM + colA) = pack8(v);
                    if (lane < 32) { unpack8(yv[r][1], v);
#pragma unroll
                        for (int i = 0; i < 8; ++i) v[i] = v[i] * r_att * nwB[i];
                        *(u32x4*)(ycat + (size_t)m * DM + colB) = pack8(v); } } }
            }
            GRID_SYNC();
#endif
            }
#if PH & 512
            {
                pg8::Gemm g{ycat, Wl + WL_OUT / 2, MTOK, DM, DM}; pg8::StaticOrder S; S.init(MTOK, DM, G, bid);
                EpiResid E{xb, ssq + (size_t)(3 * layer + 2) * MTOK * 4, 1.0f, (LAS float*)(lds + 131072)};
                pg8::gemm_phase<EpiResid, pg8::StaticOrder, true, true>(lds, g, S, E);
            }
            GRID_SYNC();
#endif
        }
    }
#if PH & 1024
    for (int m0 = gw; m0 < MTOK; m0 += 4 * NGW) {
        PHASE_IDS();
        u32x4 xv[4][2]; f32x4 pv4[4];
#pragma unroll
        for (int r = 0; r < 4; ++r) { const int m = min(m0 + r * NGW, MTOK - 1);
            const u32x4* xr = (const u32x4*)(xb + (size_t)m * DM) + lane; xv[r][0] = xr[0]; xv[r][1] = xr[64];
            pv4[r] = *(const f32x4*)(ssq + (size_t)6 * MTOK * 4 + (size_t)m * 4); }
        const f32x4* wv = (const f32x4*)args.in[26];
        f32x4 wq[2][2];
#pragma unroll
        for (int j = 0; j < 2; ++j) { const int c4 = (64 * j + lane) * 2; wq[j][0] = wv[c4]; wq[j][1] = wv[c4 + 1]; }
#pragma unroll
        for (int r = 0; r < 4; ++r) { const int m = m0 + r * NGW; if (m < MTOK) {
            const float rs = rstd4(pv4[r]); f32x4* orow = (f32x4*)(args.out + (size_t)m * DM);
#pragma unroll
            for (int j = 0; j < 2; ++j) {
                float v[8]; unpack8(xv[r][j], v);
                const int c4 = (64 * j + lane) * 2; const f32x4 w0 = wq[j][0], w1 = wq[j][1];
                orow[c4] = (f32x4){v[0] * rs * w0.x, v[1] * rs * w0.y, v[2] * rs * w0.z, v[3] * rs * w0.w};
                orow[c4 + 1] = (f32x4){v[4] * rs * w1.x, v[5] * rs * w1.y, v[6] * rs * w1.z, v[7] * rs * w1.w};
            } } }
    }
#endif
}

extern "C" void kernel_launch(void* const* d_in, const int* in_sizes, int n_in, void* d_out, int out_size, void* d_ws, size_t ws_size, hipStream_t stream) {
    static int grid = 0;
    if (grid == 0) {
        if (n_in != 27 || out_size != MTOK * DM || ws_size < WS_END) { fprintf(stderr, "kernel_launch: unexpected shapes (n_in %d, out %d, ws %zu)\n", n_in, out_size, ws_size); grid = -1; return; }
        int dev = 0, cus = 0, per_cu = 0;
        hipGetDevice(&dev); hipDeviceGetAttribute(&cus, hipDeviceAttributeMultiprocessorCount, dev);
        if (hipFuncSetAttribute((const void*)fwd_megakernel, hipFuncAttributeMaxDynamicSharedMemorySize, LDS_BYTES) != hipSuccess) { fprintf(stderr, "kernel_launch: hipFuncSetAttribute failed\n"); grid = -1; return; }
        if (hipOccupancyMaxActiveBlocksPerMultiprocessor(&per_cu, (const void*)fwd_megakernel, 512, LDS_BYTES) != hipSuccess || per_cu < 1) { fprintf(stderr, "kernel_launch: occupancy query gave %d\n", per_cu); per_cu = 1; }
        (void)hipGetLastError();
        grid = cus * 1;
        fprintf(stderr, "kernel_launch: cus %d per_cu %d grid %d\n", cus, per_cu, grid);
    }
    if (grid < 0) return;
    if (hipMemsetAsync((char*)d_ws + WS_BAR, 0, XCD_BAR_WORDS * 4, stream) != hipSuccess) { fprintf(stderr, "kernel_launch: memset failed\n"); return; }
    Args a{};
    for (int i = 0; i < 27; ++i) a.in[i] = (const float*)d_in[i];
    a.out = (float*)d_out; a.ws = (unsigned char*)d_ws;
    void* kargs[] = {&a};
    hipError_t e = hipLaunchCooperativeKernel((const void*)fwd_megakernel, dim3(grid), dim3(512), kargs, LDS_BYTES, stream);
    if (e != hipSuccess) fprintf(stderr, "kernel_launch: cooperative launch failed: %s (grid %d)\n", hipGetErrorString(e), grid);
}
```
